# Optimizing an MI355X kernel written in HIP

```python
import math
import jax, jax.numpy as jnp
from jax import lax
import numpy as np

D_MODEL = 1024
BATCH = 16
SEQ = 2048
DEPTH = 1

D_CONV = D_MODEL // 2
CONV_WIDTH = 3
D_SSM = D_MODEL // 2
SSM_GROUP = 16
N_SSM_GROUPS = D_SSM // SSM_GROUP
SSM_STATE = 64
DT_MIN = 0.001
DT_MAX = 0.1
D_IN_PROJ = 3 * D_CONV + D_SSM + 2 * D_MODEL
N_EXPERTS = 32
TOP_K = 4
D_FF = D_MODEL
SWIGLU_LIMIT = 7.0
SWIGLU_ALPHA = 1.702
MOE_BLOCK = 512
RMS_EPS = 1e-6

kernel_name = "hybrid_conv_s5_gated_moe"


def rmsnorm(x, g):
    xf = x.astype(jnp.float32)
    y = xf * lax.rsqrt(jnp.mean(xf * xf, axis=-1, keepdims=True) + RMS_EPS)
    return (y * g.astype(jnp.float32)).astype(x.dtype)


def short_conv_mixer(b_gate, c_gate, v, conv_w, w_conv_out):
    seq = v.shape[1]
    h = c_gate * v
    hp = jnp.pad(h, ((0, 0), (CONV_WIDTH - 1, 0), (0, 0)))
    z = conv_w[0] * hp[:, 0:seq]
    for k in range(1, CONV_WIDTH):
        z = z + conv_w[k] * hp[:, k:k + seq]
    return (b_gate * z) @ w_conv_out


def s5_mixer(u, lam_re, lam_im, log_dt, b_re, b_im, c_re, c_im, d_skip, w_glu):
    bsz, seq, _ = u.shape
    uf = u.astype(jnp.float32).reshape(bsz, seq, N_SSM_GROUPS, SSM_GROUP)
    lam = lax.complex(lam_re.astype(jnp.float32), lam_im.astype(jnp.float32))
    dt = jnp.exp(log_dt.astype(jnp.float32))[:, None]
    lam_bar = jnp.exp(lam * dt)
    b_c = lax.complex(b_re.astype(jnp.float32), b_im.astype(jnp.float32))
    b_bar = ((lam_bar - 1.0) / lam)[..., None] * b_c
    c_c = lax.complex(c_re.astype(jnp.float32), c_im.astype(jnp.float32))
    bu = jnp.einsum('bsgc,gpc->bsgp', uf.astype(jnp.complex64), b_bar)
    a = jnp.broadcast_to(lam_bar, (1, seq, N_SSM_GROUPS, SSM_STATE))

    def combine(e_i, e_j):
        a_i, b_i = e_i
        a_j, b_j = e_j
        return a_j * a_i, a_j * b_i + b_j

    _, states = lax.associative_scan(combine, (a, bu), axis=1)
    y = jnp.real(jnp.einsum('bsgp,gcp->bsgc', states, c_c))
    y = y + d_skip.astype(jnp.float32).reshape(N_SSM_GROUPS, SSM_GROUP) * uf
    y = jax.nn.gelu(y.reshape(bsz, seq, D_SSM)).astype(u.dtype)
    val, gate = jnp.split(y @ w_glu, 2, axis=-1)
    return val * jax.nn.sigmoid(gate)


def moe_ffn(x, w_router, b_router, w_gate_up, b_gate_up, w_down, b_down):
    bsz, seq, d = x.shape
    n_tok = bsz * seq
    xf = x.reshape(n_tok, d)
    logits = xf.astype(jnp.float32) @ w_router.astype(jnp.float32) + b_router.astype(jnp.float32)
    top_v, top_i = lax.top_k(logits, TOP_K)
    gates = jax.nn.softmax(top_v, axis=-1).astype(x.dtype)
    n_assign = n_tok * TOP_K
    flat_e = top_i.reshape(-1)
    order = jnp.argsort(flat_e)
    sorted_e = flat_e[order]
    sorted_tok = (order // TOP_K).astype(jnp.int32)
    counts = jnp.bincount(flat_e, length=N_EXPERTS)
    padded = ((counts + MOE_BLOCK - 1) // MOE_BLOCK) * MOE_BLOCK
    pad_end = jnp.cumsum(padded)
    pad_start = pad_end - padded
    un_start = jnp.cumsum(counts) - counts
    dest = (pad_start[sorted_e] + (jnp.arange(n_assign) - un_start[sorted_e])).astype(jnp.int32)
    n_rows = n_assign + N_EXPERTS * MOE_BLOCK
    n_blocks = n_rows // MOE_BLOCK
    row_tok = jnp.full((n_rows,), n_tok, jnp.int32).at[dest].set(sorted_tok)
    block_e = jnp.minimum(
        jnp.searchsorted(pad_end, jnp.arange(n_blocks) * MOE_BLOCK, side='right'), N_EXPERTS - 1)
    x_pad = jnp.concatenate([xf, jnp.zeros((1, d), xf.dtype)], axis=0)
    x_rows = x_pad[row_tok].reshape(n_blocks, MOE_BLOCK, d)

    def expert_block(args):
        xb, e = args
        h = xb @ w_gate_up[e] + b_gate_up[e]
        g, up = jnp.split(h, 2, axis=-1)
        g = jnp.minimum(g, SWIGLU_LIMIT)
        up = jnp.clip(up, -SWIGLU_LIMIT, SWIGLU_LIMIT)
        act = (up + 1.0) * (g * jax.nn.sigmoid(SWIGLU_ALPHA * g))
        return act @ w_down[e] + b_down[e]

    y_rows = lax.map(expert_block, (x_rows, block_e)).reshape(n_rows, d)
    dest_flat = jnp.zeros((n_assign,), jnp.int32).at[order].set(dest)
    y_assign = y_rows[dest_flat].reshape(n_tok, TOP_K, d)
    y = jnp.einsum('tk,tkd->td', gates, y_assign)
    return y.reshape(bsz, seq, d)


def setup_inputs(seed: int = 0) -> dict:
    key = jax.random.key(seed)
    ks = jax.random.split(key, 24)
    f32 = jnp.float32
    nrm = lambda k, shape, s: jax.random.normal(k, shape, f32) * s
    x = jax.random.normal(ks[0], (BATCH, SEQ, D_MODEL), f32)
    norm_mix_g = 1.0 + nrm(ks[1], (DEPTH, D_MODEL), 0.02)
    w_in = nrm(ks[2], (DEPTH, D_MODEL, D_IN_PROJ), D_MODEL ** -0.5)
    conv_w = nrm(ks[3], (DEPTH, CONV_WIDTH, D_CONV), CONV_WIDTH ** -0.5)
    w_conv_out = nrm(ks[4], (DEPTH, D_CONV, D_MODEL), D_CONV ** -0.5)
    ssm_lam_re = -0.5 + nrm(ks[5], (DEPTH, N_SSM_GROUPS, SSM_STATE), 0.01)
    ssm_lam_im = (jnp.pi * jnp.arange(SSM_STATE, dtype=f32)) + nrm(ks[6], (DEPTH, N_SSM_GROUPS, SSM_STATE), 0.01)
    ssm_log_dt = jax.random.uniform(ks[7], (DEPTH, N_SSM_GROUPS), f32,
                                    minval=math.log(DT_MIN), maxval=math.log(DT_MAX))
    ssm_b_re = nrm(ks[8], (DEPTH, N_SSM_GROUPS, SSM_STATE, SSM_GROUP), (2 * SSM_GROUP) ** -0.5)
    ssm_b_im = nrm(ks[9], (DEPTH, N_SSM_GROUPS, SSM_STATE, SSM_GROUP), (2 * SSM_GROUP) ** -0.5)
    ssm_c_re = nrm(ks[10], (DEPTH, N_SSM_GROUPS, SSM_GROUP, SSM_STATE), (2 * SSM_STATE) ** -0.5)
    ssm_c_im = nrm(ks[11], (DEPTH, N_SSM_GROUPS, SSM_GROUP, SSM_STATE), (2 * SSM_STATE) ** -0.5)
    ssm_d = nrm(ks[12], (DEPTH, D_SSM), 1.0)
    w_glu = nrm(ks[13], (DEPTH, D_SSM, 2 * D_MODEL), D_SSM ** -0.5)
    w_out = nrm(ks[14], (DEPTH, D_MODEL, D_MODEL), D_MODEL ** -0.5)
    norm_ffn_g = 1.0 + nrm(ks[15], (DEPTH, D_MODEL), 0.02)
    w_router = nrm(ks[16], (DEPTH, D_MODEL, N_EXPERTS), D_MODEL ** -0.5)
    b_router = nrm(ks[17], (DEPTH, N_EXPERTS), 0.01)
    w_gate_up = nrm(ks[18], (DEPTH, N_EXPERTS, D_MODEL, 2 * D_FF), D_MODEL ** -0.5)
    b_gate_up = nrm(ks[19], (DEPTH, N_EXPERTS, 2 * D_FF), 0.01)
    w_down = nrm(ks[20], (DEPTH, N_EXPERTS, D_FF, D_MODEL), D_FF ** -0.5)
    b_down = nrm(ks[21], (DEPTH, N_EXPERTS, D_MODEL), 0.01)
    norm_f_g = 1.0 + nrm(ks[22], (D_MODEL,), 0.02)
    return {"x": x, "norm_mix_g": norm_mix_g, "w_in": w_in, "conv_w": conv_w,
            "w_conv_out": w_conv_out, "ssm_lam_re": ssm_lam_re, "ssm_lam_im": ssm_lam_im,
            "ssm_log_dt": ssm_log_dt, "ssm_b_re": ssm_b_re, "ssm_b_im": ssm_b_im,
            "ssm_c_re": ssm_c_re, "ssm_c_im": ssm_c_im, "ssm_d": ssm_d, "w_glu": w_glu,
            "w_out": w_out, "norm_ffn_g": norm_ffn_g, "w_router": w_router,
            "b_router": b_router, "w_gate_up": w_gate_up, "b_gate_up": b_gate_up,
            "w_down": w_down, "b_down": b_down, "norm_f_g": norm_f_g}


def reference(x, norm_mix_g, w_in, conv_w, w_conv_out, ssm_lam_re, ssm_lam_im, ssm_log_dt,
              ssm_b_re, ssm_b_im, ssm_c_re, ssm_c_im, ssm_d, w_glu, w_out, norm_ffn_g,
              w_router, b_router, w_gate_up, b_gate_up, w_down, b_down, norm_f_g):
    splits = [D_CONV, 2 * D_CONV, 3 * D_CONV, 3 * D_CONV + D_SSM, 3 * D_CONV + D_SSM + D_MODEL]
    for l in range(DEPTH):
        h = rmsnorm(x, norm_mix_g[l])
        proj = h @ w_in[l]
        b_gate, c_gate, v, u, gate_a, gate_b = jnp.split(proj, splits, axis=-1)
        y_a = short_conv_mixer(b_gate, c_gate, v, conv_w[l], w_conv_out[l])
        y_b = s5_mixer(u, ssm_lam_re[l], ssm_lam_im[l], ssm_log_dt[l], ssm_b_re[l], ssm_b_im[l],
                       ssm_c_re[l], ssm_c_im[l], ssm_d[l], w_glu[l])
        merged = jax.nn.sigmoid(gate_a) * y_a + jax.nn.sigmoid(gate_b) * y_b
        x = x + merged @ w_out[l]
        h = rmsnorm(x, norm_ffn_g[l])
        x = x + moe_ffn(h, w_router[l], b_router[l], w_gate_up[l], b_gate_up[l],
                        w_down[l], b_down[l])
    return rmsnorm(x, norm_f_g)
```

```cpp
#include <hip/hip_runtime.h>
#include <cstdio>
#include <cstdint>

#ifndef PROBE_DUP_HOST
#define PROBE_DUP_HOST -1
#endif
#ifndef PROBE_DUP
#define PROBE_DUP -1
#endif
#ifndef MK_N_LAUNCHES
#define MK_N_LAUNCHES 1
#endif

#define LAS __attribute__((address_space(3)))
#define GAS __attribute__((address_space(1)))
typedef unsigned short bf16_t;
typedef short bf16x8 __attribute__((ext_vector_type(8)));
typedef float f32x4 __attribute__((ext_vector_type(4)));
typedef float f32x2 __attribute__((ext_vector_type(2)));
typedef unsigned u32x4 __attribute__((ext_vector_type(4)));
typedef unsigned u32x2 __attribute__((ext_vector_type(2)));
typedef int i32x4 __attribute__((ext_vector_type(4)));
typedef int i32x8 __attribute__((ext_vector_type(8)));
constexpr float Y8_SCALE = 8.f;
constexpr float W8_SCALE = 32.f, W8_INV = 1.f / 32.f;

constexpr int DM = 1024, NB = 16, SEQ = 2048, T = NB * SEQ;
constexpr int DC = 512, DS = 512, NG = 32, GC = 16, NP = 64;
constexpr int DIN = 4096, NE = 32, TOPK = 4, DFF = 1024;
constexpr int CL = 64, NCH = SEQ / CL;
constexpr int AGK = CL * GC + 2 * NP;
constexpr int AGU = 2 * NP;
constexpr int AGROWS = NB * NCH;
constexpr float RMS_EPS = 1e-6f;
constexpr int TAPS_GST = 80 * 512;
constexpr int WRS = 1032;
constexpr int NWAVES = 8, NTHR = 512;
constexpr int ROWS_PAD_MAX = T * TOPK + NE * 256;
constexpr int ACT_LD = DFF;

constexpr size_t MiB = 1u << 20;
constexpr size_t WS_CTL = 0, CTL_ZERO_BYTES = 32768;
constexpr size_t WS_LAML = 1 * MiB;
constexpr size_t WS_GATES = 2 * MiB;
constexpr size_t WS_SLOTS = 2 * MiB + 512 * 1024;
constexpr size_t WS_WIN = 4 * MiB;
constexpr size_t WS_WIN8 = 8 * MiB;
constexpr size_t WS_WCO = 12 * MiB;
constexpr size_t WS_WGLU = 13 * MiB;
constexpr size_t WS_WOUT = 15 * MiB;
constexpr size_t WS_PT = 17 * MiB;
constexpr size_t WS_MQT = 33 * MiB;
constexpr size_t WS_LIST = 105 * MiB;
constexpr size_t WS_KTAB = 109 * MiB;
constexpr size_t WS_BGU32 = 111 * MiB;
constexpr size_t WS_WRIMG = 111 * MiB + 512 * 1024;
constexpr size_t WS_WGU = 112 * MiB;
constexpr size_t WS_WD = 240 * MiB;
constexpr size_t WS_H2B = 304 * MiB;
constexpr size_t WS_XB = 368 * MiB;
constexpr size_t WS_AG = 432 * MiB;
constexpr size_t WS_CV = 468 * MiB;
constexpr size_t WS_BQ = 500 * MiB;
constexpr size_t WS_SGA = 532 * MiB;
constexpr size_t WS_SGB = 596 * MiB;
constexpr size_t WS_ACONV = 660 * MiB;
constexpr size_t WS_YB = 692 * MiB;
constexpr size_t WS_T1 = 724 * MiB;
constexpr size_t WS_ACT = 368 * MiB;
constexpr size_t WS_YROWS = 640 * MiB;
constexpr size_t WS_X1B = 912 * MiB;
constexpr size_t WS_END = 976 * MiB;
constexpr size_t WS_OUT2 = 368 * MiB;
constexpr int CW_BAR = 4096;
constexpr int CW_CNT = 8192;
constexpr int CW_RSS = 131072;

constexpr int RING_BYTES = 131072;
constexpr int EPI_PREF_OFF = 131072;
constexpr int P6X_OFF = 132096;
constexpr int LCTL_OFF = 140 * 1024;
constexpr int LDS_BYTES = 147456;

#define LDS_WAIT() asm volatile("s_waitcnt lgkmcnt(0)" ::: "memory")
#define VM_WAIT() asm volatile("s_waitcnt vmcnt(0)" ::: "memory")
#define RLX_AGENT __ATOMIC_RELAXED, __HIP_MEMORY_SCOPE_AGENT
__device__ __forceinline__ unsigned f2bf(float f) { unsigned u = __builtin_bit_cast(unsigned, f); return (u + 0x7fffu + ((u >> 16) & 1u)) >> 16; }
__device__ __forceinline__ unsigned pk2(float lo, float hi) { return f2bf(lo) | (f2bf(hi) << 16); }
typedef __bf16 bf16x2_t __attribute__((ext_vector_type(2)));
__device__ __forceinline__ unsigned cvt_pk_bf16(float lo, float hi) { const f32x2 v = {lo, hi}; const bf16x2_t b = __builtin_convertvector(v, bf16x2_t); return __builtin_bit_cast(unsigned, b); }
__device__ __forceinline__ unsigned pk4_fp8(float a, float b, float c, float d) { int w = 0; w = __builtin_amdgcn_cvt_pk_fp8_f32(a, b, w, false); w = __builtin_amdgcn_cvt_pk_fp8_f32(c, d, w, true); return (unsigned)w; }
__device__ __forceinline__ float bf_lo(unsigned w) { return __builtin_bit_cast(float, w << 16); }
__device__ __forceinline__ float bf_hi(unsigned w) { return __builtin_bit_cast(float, w & 0xffff0000u); }
__device__ __forceinline__ float sigm(float x) { return __builtin_amdgcn_rcpf(1.f + __expf(-x)); }
__device__ __forceinline__ f32x4 sigm4(f32x4 v) { return (f32x4){sigm(v[0]), sigm(v[1]), sigm(v[2]), sigm(v[3])}; }
__device__ __forceinline__ float gelu_tanh(float x) { return x * sigm(1.5957691216f * (x + 0.044715f * x * x * x)); }
__device__ __forceinline__ u32x4 pack8(f32x4 a, f32x4 b) { u32x4 w; w.x = cvt_pk_bf16(a[0], a[1]); w.y = cvt_pk_bf16(a[2], a[3]); w.z = cvt_pk_bf16(b[0], b[1]); w.w = cvt_pk_bf16(b[2], b[3]); return w; }
__device__ __forceinline__ void unpack8(u32x4 w, f32x4& a, f32x4& b) { a = (f32x4){bf_lo(w.x), bf_hi(w.x), bf_lo(w.y), bf_hi(w.y)}; b = (f32x4){bf_lo(w.z), bf_hi(w.z), bf_lo(w.w), bf_hi(w.w)}; }
__device__ __forceinline__ float wave_sum(float v) {
#pragma unroll
    for (int o = 1; o < 64; o <<= 1) v += __shfl_xor(v, o);
    return v;
}
__device__ __forceinline__ float wave_max(float v) {
#pragma unroll
    for (int o = 1; o < 64; o <<= 1) v = fmaxf(v, __shfl_xor(v, o));
    return v;
}

__device__ __forceinline__ int fresh_tid() { int t = threadIdx.x; asm volatile("" : "+v"(t)); __builtin_assume(t >= 0 && t < 512); return t; }
namespace pg8 {
constexpr int BM = 256, BK = 64, HALF = 128, HTB = HALF * BK * 2, STAGE_BYTES = 8 * HTB;
__host__ __device__ __forceinline__ int lds_byte(int r, int c) { const int st = (r >> 4) * 2 + (c >> 5), rr = r & 15, cc = c & 31, ob = rr * 64 + cc * 2; return st * 1024 + (ob ^ (((ob >> 9) & 1) << 5)); }
__host__ __device__ __forceinline__ void stage_rc(int b, int& R, int& C) { const int st = b / 1024, sb = b % 1024, swz = sb ^ (((sb >> 9) & 1) << 5); R = (st >> 1) * 16 + swz / 64; C = (st & 1) * 32 + (swz % 64) / 2; }
__host__ __device__ __forceinline__ int perm32(int rho) { const int n = rho >> 4, i = rho & 15; return 8 * (i >> 2) + 4 * n + (i & 3); }

struct Unit { int pm, pn, e, rb, nt, mode; };

template <class Epi, class Sched, bool ALIGN_EPI, bool SP2, bool F8 = false>
__device__ __forceinline__ void gemm_phase(LAS unsigned char* lds, const Sched& S, const Epi& E) {
    const int tid = fresh_tid(), wid = __builtin_amdgcn_readfirstlane(tid >> 6), lane = tid & 63, wr = wid >> 2, wc = wid & 3, fr = lane & 15, fq = lane >> 4;
    int Rr[2], Cc[2]; unsigned voffB[2], voffA[2], voffT[2];
#pragma unroll
    for (int i = 0; i < 2; ++i) { stage_rc(tid * 16 + i * 8192, Rr[i], Cc[i]);
        const int Rb = Epi::WIDE ? (16 * (4 * (Rr[i] >> 5) + ((Rr[i] & 15) >> 2)) + 4 * ((Rr[i] >> 4) & 1) + (Rr[i] & 3)) : Epi::PERM ? ((Rr[i] & ~31) + perm32(Rr[i] & 31)) : Rr[i];
        voffB[i] = (unsigned)(Rb * S.ldb + Cc[i]) * 2u; voffA[i] = (unsigned)(Rr[i] * S.lda + Cc[i]) * 2u;
        voffT[i] = (unsigned)(Rb * 32 + (3 - (Cc[i] >> 4)) * 512 + (Cc[i] & 15) * 2); }
    const size_t hstepA = (size_t)HALF * S.lda * 2;
    const size_t kstep = (size_t)(BK * 2);
    const size_t hstepB = (size_t)(Epi::WIDE ? 8 : HALF) * S.ldb * 2;
    const unsigned ldsw = (unsigned)wid * 1024u;
    const int aoff = lds_byte(wr * 64 + fr, fq * 8), boff = lds_byte(wc * 32 + fr, fq * 8);
#define PG8_SA(b, h) (((b) * 2 + (h)) * HTB)
#define PG8_SB(b, h) ((4 + (b) * 2 + (h)) * HTB)
#define PG8_STAGE(bufoff, gbase, o0, o1) do { \
        __builtin_amdgcn_global_load_lds((const unsigned*)((const char*)(gbase) + (o0)), (LAS unsigned*)(lds + (bufoff) + ldsw), 16, 0, 0); \
        __builtin_amdgcn_global_load_lds((const unsigned*)((const char*)(gbase) + (o1)), (LAS unsigned*)(lds + (bufoff) + ldsw + 8192), 16, 0, 0); } while (0)
#define PG8_STAGE_B(bufoff, gbase) PG8_STAGE(bufoff, gbase, voffB[0], voffB[1])
#define PG8_STAGE_BT(bufoff, gbase, h) do { if constexpr (Sched::TOEP) { if (last) PG8_STAGE(bufoff, (gbase) + (h) * hstepB, voffB[0], voffB[1]); else PG8_STAGE(bufoff, (gbase) + (h) * 4096, voffT[0], voffT[1]); } \
        else PG8_STAGE(bufoff, (gbase) + (h) * hstepB, voffB[0], voffB[1]); } while (0)
#define PG8_STAGE_A(bufoff, gbase, h, o0, o1) do { if constexpr (Sched::GATHER) PG8_STAGE(bufoff, gbase, o0, o1); else PG8_STAGE(bufoff, (gbase) + (h) * hstepA, voffA[0], voffA[1]); } while (0)
#define PG8_LD8(off) __builtin_shufflevector(*(const LAS i32x4*)(lds + (off)), *(const LAS i32x4*)(lds + (off) + 1024), 0, 1, 2, 3, 4, 5, 6, 7)
#define PG8_LDA(dst, b, h) do { if constexpr (F8) { _Pragma("unroll") for (int m = 0; m < 4; ++m) dst##8[m] = PG8_LD8(PG8_SA(b, h) + aoff + m * 2048); } \
        else { _Pragma("unroll") for (int m = 0; m < 4; ++m) _Pragma("unroll") for (int k = 0; k < 2; ++k) dst[m][k] = *(const LAS bf16x8*)(lds + PG8_SA(b, h) + aoff + m * 2048 + k * 1024); } } while (0)
#define PG8_LDB(dst, b, h) do { if constexpr (F8) { _Pragma("unroll") for (int n = 0; n < 2; ++n) dst##8[n] = PG8_LD8(PG8_SB(b, h) + boff + n * 2048); } \
        else { _Pragma("unroll") for (int n = 0; n < 2; ++n) _Pragma("unroll") for (int k = 0; k < 2; ++k) dst[n][k] = *(const LAS bf16x8*)(lds + PG8_SB(b, h) + boff + n * 2048 + k * 1024); } } while (0)
#define PG8_MMA(ai, bj, At, Bt) do { __builtin_amdgcn_s_setprio(1); _Pragma("unroll") for (int m = 0; m < 4; ++m) _Pragma("unroll") for (int n = 0; n < 2; ++n) { \
        if constexpr (F8) { asm volatile("v_mfma_f32_16x16x128_f8f6f4 %0, %1, %2, %0" : "+v"(acc[ai][bj][m][n]) : "v"(Bt##8[n]), "v"(At##8[m])); } \
        else { _Pragma("unroll") for (int k = 0; k < 2; ++k) acc[ai][bj][m][n] = __builtin_amdgcn_mfma_f32_16x16x32_bf16(Bt[n][k], At[m][k], acc[ai][bj][m][n], 0, 0, 0); } } \
        __builtin_amdgcn_s_setprio(0); } while (0)
#define PG8_MMA_C(ai, bj, At, Bt) do { if constexpr (Epi::FUSED2) { if ((bj) == 1 || cur.mode != 2) PG8_MMA(ai, bj, At, Bt); } else if constexpr (Epi::HALFN) { if ((bj) == 0) PG8_MMA(ai, bj, At, Bt); } else PG8_MMA(ai, bj, At, Bt); } while (0)
#define PG8_WAIT_V(n) asm volatile("s_waitcnt vmcnt(" #n ")" ::: "memory")
#define PG8_WAIT_L(n) asm volatile("s_waitcnt lgkmcnt(" #n ")" ::: "memory")
#define PG8_BAR __builtin_amdgcn_s_barrier()
#define PG8_SCHED __builtin_amdgcn_sched_barrier(0)
    Unit cur, nxt; int ui = 0;
    if (!S.next(0, cur)) return;
    int nt = cur.nt;
    f32x4 acc[2][2][4][2];
#pragma unroll
    for (int a = 0; a < 2; ++a)
#pragma unroll
        for (int b = 0; b < 2; ++b)
#pragma unroll
            for (int m = 0; m < 4; ++m)
#pragma unroll
                for (int n = 0; n < 2; ++n) acc[a][b][m][n] = (f32x4){0.f, 0.f, 0.f, 0.f};
    if constexpr (Epi::BIASINIT) { cur.mode = 0; E.pref(cur, lds, wid, lane); asm volatile("s_waitcnt vmcnt(0)" ::: "memory"); E.init(acc, cur, wr, wc, fr, fq); }
#define PG8_ACC16(a, OP) OP(acc[a][0][0][0]), OP(acc[a][0][0][1]), OP(acc[a][0][1][0]), OP(acc[a][0][1][1]), OP(acc[a][0][2][0]), OP(acc[a][0][2][1]), OP(acc[a][0][3][0]), OP(acc[a][0][3][1]), \
                         OP(acc[a][1][0][0]), OP(acc[a][1][0][1]), OP(acc[a][1][1][0]), OP(acc[a][1][1][1]), OP(acc[a][1][2][0]), OP(acc[a][1][2][1]), OP(acc[a][1][3][0]), OP(acc[a][1][3][1])
#define PG8_PV(x) "+v"(x)
#define PG8_ACC_ANCHOR() do { if constexpr (F8) { asm volatile("" : PG8_ACC16(0, PG8_PV)); asm volatile("" : PG8_ACC16(1, PG8_PV)); } } while (0)
#define PG8_ACC_SETTLE() do { if constexpr (F8) { asm volatile("s_nop 15\n\ts_nop 15" : PG8_ACC16(0, PG8_PV)); asm volatile("s_nop 15\n\ts_nop 15" : PG8_ACC16(1, PG8_PV)); } } while (0)
    PG8_ACC_ANCHOR();
    bf16x8 At[4][2], B0[2][2], B1[2][2]; i32x8 At8[4], B08[2], B18[2];
    const char* cA; const char* cB; unsigned avo[2][2];
    S.addr(cur, cA, cB, avo, Rr, Cc);
    const char* cT = nullptr; if constexpr (Sched::TOEP) { static_assert(SP2, "TOEP needs the SP2 loop"); cT = S.tptr(cur); }
    if constexpr (SP2) {
        PG8_STAGE_B(PG8_SB(0, 0), cB); PG8_STAGE_B(PG8_SB(0, 1), cB + hstepB); PG8_STAGE_A(PG8_SA(0, 0), cA, 0, avo[0][0], avo[0][1]); PG8_STAGE_A(PG8_SA(0, 1), cA, 1, avo[1][0], avo[1][1]);
        if (wr == 1) PG8_BAR;
        PG8_WAIT_V(2); PG8_BAR;
        PG8_STAGE_B(PG8_SB(1, 0), cB + kstep); PG8_STAGE_A(PG8_SA(1, 0), cA + kstep, 0, avo[0][0], avo[0][1]); PG8_STAGE_B(PG8_SB(1, 1), cB + hstepB + kstep);
        PG8_WAIT_V(6); PG8_BAR;
    } else {
        PG8_STAGE_B(PG8_SB(0, 0), cB); PG8_STAGE_A(PG8_SA(0, 0), cA, 0, avo[0][0], avo[0][1]); PG8_STAGE_B(PG8_SB(0, 1), cB + hstepB); PG8_STAGE_A(PG8_SA(0, 1), cA, 1, avo[1][0], avo[1][1]);
        if (wr == 1) PG8_BAR;
        PG8_WAIT_V(4); PG8_BAR;
        PG8_STAGE_B(PG8_SB(1, 0), cB + kstep); PG8_STAGE_A(PG8_SA(1, 0), cA + kstep, 0, avo[0][0], avo[0][1]); PG8_STAGE_B(PG8_SB(1, 1), cB + hstepB + kstep);
        PG8_WAIT_V(6); PG8_BAR;
    }
    for (;;) {
        const bool has_next = S.next(ui + 1, nxt);
        const char* nA = cA; const char* nB = cB; unsigned navo[2][2] = {{avo[0][0], avo[0][1]}, {avo[1][0], avo[1][1]}};
        if (has_next) S.addr(nxt, nA, nB, navo, Rr, Cc);
        const char* nT = cT; if constexpr (Sched::TOEP) { if (has_next) nT = S.tptr(nxt); }
        if constexpr (Epi::BIASINIT) { nxt.mode = (ui + 1) & 1; if (has_next) E.pref(nxt, lds, wid, lane); }
        else if constexpr (Epi::PREF) { cur.mode = 0; E.pref(cur, lds, wid, lane); }
        for (int t = 0; t < nt; t += 2) {
            const bool last = (t == nt - 2);
            const char* a1 = cA + (size_t)(t + 1) * kstep;
            const char* a2 = last ? nA : cA + (size_t)(t + 2) * kstep; const char* b2 = last ? nB : (Sched::TOEP ? cT - (size_t)t * 2048 : cB + (size_t)(t + 2) * kstep);
            const char* a3 = a2 + kstep; const char* b3 = (Sched::TOEP && !last) ? b2 - 2048 : b2 + kstep;
            if constexpr (SP2) {
            PG8_LDB(B0, 0, 0); if constexpr (!Epi::HALFN) PG8_LDB(B1, 0, 1); PG8_SCHED; PG8_LDA(At, 0, 0); PG8_STAGE_A(PG8_SA(1, 1), a1, 1, avo[1][0], avo[1][1]);
            PG8_WAIT_V(8); PG8_WAIT_L(0); PG8_BAR; PG8_MMA_C(0, 0, At, B0); PG8_MMA_C(0, 1, At, B1); PG8_BAR; PG8_SCHED;
            PG8_LDA(At, 0, 1); PG8_STAGE_BT(PG8_SB(0, 0), b2, 0); PG8_STAGE_BT(PG8_SB(0, 1), b2, 1); PG8_STAGE_A(PG8_SA(0, 0), a2, 0, (last ? navo[0][0] : avo[0][0]), (last ? navo[0][1] : avo[0][1]));
            PG8_WAIT_V(8); PG8_WAIT_L(0); PG8_BAR; PG8_MMA_C(1, 0, At, B0); PG8_MMA_C(1, 1, At, B1); PG8_BAR; PG8_SCHED;
            PG8_LDB(B0, 1, 0); if constexpr (!Epi::HALFN) PG8_LDB(B1, 1, 1); PG8_SCHED; PG8_LDA(At, 1, 0); PG8_STAGE_A(PG8_SA(0, 1), a2, 1, (last ? navo[1][0] : avo[1][0]), (last ? navo[1][1] : avo[1][1]));
            PG8_WAIT_V(8); PG8_WAIT_L(0); PG8_BAR; PG8_MMA_C(0, 0, At, B0); PG8_MMA_C(0, 1, At, B1); PG8_BAR; PG8_SCHED;
            PG8_LDA(At, 1, 1); PG8_STAGE_BT(PG8_SB(1, 0), b3, 0); PG8_STAGE_BT(PG8_SB(1, 1), b3, 1); PG8_STAGE_A(PG8_SA(1, 0), a3, 0, (last ? navo[0][0] : avo[0][0]), (last ? navo[0][1] : avo[0][1]));
            PG8_WAIT_V(8); PG8_WAIT_L(0); PG8_BAR; PG8_MMA_C(1, 0, At, B0); PG8_MMA_C(1, 1, At, B1); PG8_BAR; PG8_SCHED;
            } else {
            PG8_LDB(B0, 0, 0); PG8_SCHED; PG8_LDA(At, 0, 0); PG8_STAGE_A(PG8_SA(1, 1), a1, 1, avo[1][0], avo[1][1]);
            PG8_WAIT_L(8); PG8_BAR; PG8_WAIT_L(0); PG8_MMA_C(0, 0, At, B0); PG8_BAR; PG8_SCHED;
            PG8_LDB(B1, 0, 1); PG8_STAGE_B(PG8_SB(0, 0), b2);
            PG8_BAR; PG8_WAIT_L(0); PG8_MMA_C(0, 1, At, B1); PG8_BAR;
            PG8_LDA(At, 0, 1); PG8_STAGE_A(PG8_SA(0, 0), a2, 0, (last ? navo[0][0] : avo[0][0]), (last ? navo[0][1] : avo[0][1]));
            PG8_BAR; PG8_WAIT_L(0); PG8_MMA_C(1, 0, At, B0); PG8_BAR; PG8_SCHED;
            PG8_STAGE_B(PG8_SB(0, 1), b2 + hstepB);
            PG8_WAIT_V(6); PG8_BAR; PG8_MMA_C(1, 1, At, B1); PG8_BAR;
            PG8_LDB(B0, 1, 0); PG8_SCHED; PG8_LDA(At, 1, 0); PG8_STAGE_A(PG8_SA(0, 1), a2, 1, (last ? navo[1][0] : avo[1][0]), (last ? navo[1][1] : avo[1][1]));
            PG8_WAIT_L(8); PG8_BAR; PG8_WAIT_L(0); PG8_MMA_C(0, 0, At, B0); PG8_BAR; PG8_SCHED;
            PG8_LDB(B1, 1, 1); PG8_STAGE_B(PG8_SB(1, 0), b3);
            PG8_BAR; PG8_WAIT_L(0); PG8_MMA_C(0, 1, At, B1); PG8_BAR;
            PG8_LDA(At, 1, 1); PG8_STAGE_A(PG8_SA(1, 0), a3, 0, (last ? navo[0][0] : avo[0][0]), (last ? navo[0][1] : avo[0][1]));
            PG8_BAR; PG8_WAIT_L(0); PG8_MMA_C(1, 0, At, B0); PG8_BAR; PG8_SCHED;
            PG8_STAGE_B(PG8_SB(1, 1), b3 + hstepB);
            PG8_WAIT_V(6); PG8_BAR; PG8_MMA_C(1, 1, At, B1); PG8_BAR;
            }
        }
        if constexpr (ALIGN_EPI) { if (wr == 0) PG8_BAR; }
        PG8_ACC_SETTLE();
        if constexpr (Epi::FUSED2) { E.stage(acc, cur, wr, wc, fr, fq); }
        else if constexpr (!Epi::AFTER_DRAIN) { E(acc, cur, wr, wc, fr, fq); }
        if (!has_next) break;
        const bool keep0 = Epi::FUSED2 && cur.mode == 1;
        if constexpr (Epi::BIASINIT) E.init(acc, nxt, wr, wc, fr, fq);
        else {
#pragma unroll
        for (int a = 0; a < 2; ++a)
#pragma unroll
            for (int b = 0; b < 2; ++b)
#pragma unroll
                for (int m = 0; m < 4; ++m)
#pragma unroll
                    for (int n = 0; n < 2; ++n) if (b == 1 || !keep0) acc[a][b][m][n] = (f32x4){0.f, 0.f, 0.f, 0.f};
        }
        PG8_ACC_ANCHOR();
        cur = nxt; nt = cur.nt; cA = nA; cB = nB; cT = nT; avo[0][0] = navo[0][0]; avo[0][1] = navo[0][1]; avo[1][0] = navo[1][0]; avo[1][1] = navo[1][1]; ++ui;
        if constexpr (ALIGN_EPI) { if (wr == 1) PG8_BAR; }
    }
    PG8_WAIT_V(0);
    if constexpr (!ALIGN_EPI) { if (wr == 0) PG8_BAR; }
    PG8_BAR;
    if constexpr (Epi::AFTER_DRAIN) { E.fused(acc, cur, wr, wc, fr, fq, lds, wid, lane); }
#undef PG8_SA
#undef PG8_SB
#undef PG8_STAGE
#undef PG8_STAGE_B
#undef PG8_STAGE_BT
#undef PG8_STAGE_A
#undef PG8_LDA
#undef PG8_ACC16
#undef PG8_PV
#undef PG8_ACC_ANCHOR
#undef PG8_ACC_SETTLE
#undef PG8_LD8
#undef PG8_LDB
#undef PG8_MMA
#undef PG8_MMA_C
#undef PG8_WAIT_V
#undef PG8_WAIT_L
#undef PG8_BAR
#undef PG8_SCHED
}
}
using pg8::Unit;

#define XB_TMO      128
#define XB_XCNT(j)  (256  + 64 * (j))
#define XB_XSUB(j)  (1280 + 64 * (j))
#define XB_XGEN(j)  (2304 + 64 * (j))
#define XB_TOP      3328
#define XB_TOPGEN   3392
#define XCD_BAR_WORDS 3456
#define XB_SPIN_CAP (1u << 18)
__device__ __forceinline__ unsigned xb_ld(unsigned* p)              { return __hip_atomic_load(p, __ATOMIC_RELAXED, __HIP_MEMORY_SCOPE_AGENT); }
__device__ __forceinline__ unsigned xb_add(unsigned* p, unsigned v) { return __hip_atomic_fetch_add(p, v, __ATOMIC_RELAXED, __HIP_MEMORY_SCOPE_AGENT); }
__device__ __forceinline__ unsigned xb_xcc_id() { return (unsigned)__builtin_amdgcn_s_getreg((3 << 11) | 20) & 0xFu; }
#define XB_SPIN(cond, bar) do { unsigned _sp = 0; while (cond) { __builtin_amdgcn_s_sleep(1); \
    if ((++_sp & 255u) == 0u) { if (xb_ld(&(bar)[XB_TMO])) break; if (_sp > XB_SPIN_CAP) { atomicAdd(&(bar)[XB_TMO], 1u); break; } } } } while (0)
struct XcdBarrier { unsigned* bar; unsigned x; volatile LAS unsigned* st; };
__device__ __forceinline__ XcdBarrier xcd_barrier_post(unsigned* bar, volatile LAS unsigned* st) {
    XcdBarrier b; b.bar = bar; b.x = xb_xcc_id(); b.st = st;
    if (threadIdx.x == 0) (void)xb_add(&bar[XB_XCNT(b.x)], 1u);
    return b;
}
__device__ __forceinline__ void xcd_barrier_complete(unsigned* bar, unsigned x, unsigned& nloc, unsigned& nx) {
    const unsigned G = gridDim.x * gridDim.y * gridDim.z;
    unsigned sum, cnt, mine, sp = 0u;
    for (;;) {
        sum = 0u; cnt = 0u; mine = 0u;
#pragma unroll
        for (unsigned j = 0; j < 16; ++j) { const unsigned c = xb_ld(&bar[XB_XCNT(j)]); sum += c; cnt += (c > 0u) ? 1u : 0u; mine = (j == x) ? c : mine; }
        if (sum == G) break;
        __builtin_amdgcn_s_sleep(1);
        if ((++sp & 255u) == 0u) { if (xb_ld(&bar[XB_TMO])) break; if (sp > XB_SPIN_CAP) { atomicAdd(&bar[XB_TMO], 1u); break; } }
    }
    nloc = mine > 0u ? mine : 1u; nx = cnt > 0u ? cnt : 1u;
}
__device__ __forceinline__ void xcd_barrier(const XcdBarrier& b) {
    asm volatile("s_waitcnt vmcnt(0)" ::: "memory");
    __syncthreads();
    if (threadIdx.x == 0) {
        unsigned* bar = b.bar;
        __builtin_amdgcn_s_waitcnt(0);
        unsigned nloc = b.st[0], nx = b.st[1];
        if (nloc == 0u) { xcd_barrier_complete(bar, b.x, nloc, nx); b.st[0] = nloc; b.st[1] = nx; }
        const unsigned old = xb_add(&bar[XB_XSUB(b.x)], 1u);
        const unsigned gen = old / nloc;
        if (old + 1u == (gen + 1u) * nloc) {
            __builtin_amdgcn_fence(__ATOMIC_RELEASE, "agent");
            asm volatile("s_waitcnt vmcnt(0)" ::: "memory");
            const unsigned og = xb_add(&bar[XB_TOP], 1u);
            const unsigned tg = og / nx;
            if (og + 1u == (tg + 1u) * nx) xb_add(&bar[XB_TOPGEN], 1u);
            else XB_SPIN(xb_ld(&bar[XB_TOPGEN]) == tg, bar);
            __builtin_amdgcn_fence(__ATOMIC_ACQUIRE, "agent");
            xb_add(&bar[XB_XGEN(b.x)], 1u);
            asm volatile("s_waitcnt vmcnt(0)" ::: "memory");
        } else {
            XB_SPIN(xb_ld(&bar[XB_XGEN(b.x)]) == gen, bar);
            __builtin_amdgcn_fence(__ATOMIC_ACQUIRE, "agent");
            asm volatile("s_waitcnt vmcnt(0)" ::: "memory");
        }
    }
    __syncthreads();
}

struct Args { const float* in[23]; float* out; unsigned char* ws; int ph_lo, ph_hi, flags, pad; };
typedef const __attribute__((address_space(4))) Args KArgs;
__device__ __forceinline__ const Args* fresh_args() { KArgs* p = (KArgs*)__builtin_amdgcn_kernarg_segment_ptr(); asm volatile("" : "+s"(p)); return (const Args*)p; }
enum { I_X = 0, I_G1, I_WIN, I_CONVW, I_WCO, I_LRE, I_LIM, I_LDT, I_BRE, I_BIM, I_CRE, I_CIM, I_D, I_WGLU, I_WOUT, I_G2, I_WR, I_BR, I_WGU, I_BGU, I_WD, I_BD, I_GF };

struct Ctx {
    LAS unsigned char* lds; int tid, lane, wave, G, vcu;
    unsigned char* ws;
};

__device__ __forceinline__ int rowmap(int mode, int n) {
    if (mode == 1) {
        if (n < 512) return 1024 + n;
        if (n < 1024) { const int ch = n - 512; return (ch >> 7) * 256 + (ch & 127); }
        if (n < 1536) { const int ch = n - 1024; return (ch >> 7) * 256 + 128 + (ch & 127); }
        return n;
    }
    if (mode == 2) { const int h = n >> 10, m = n & 1023; return (m >> 7) * 256 + h * 128 + (m & 127); }
    return n;
}
template <bool F8 = false>
__device__ __forceinline__ void p0_transpose_item(const float* W, int K, int N, void* WTv, int mode, LAS float* scr, int item, int lane, int ldw = 0) {
    bf16_t* WT = (bf16_t*)WTv;
    const int nblk = N / 32, kb = item / nblk, nb = item % nblk, k0 = 64 * kb, n0 = 32 * nb;
    const int ld = ldw ? ldw : N;
#pragma unroll 8
    for (int i = 0; i < 32; ++i) { const int kk = 2 * i + (lane >> 5); scr[kk * 33 + (lane & 31)] = W[(size_t)(k0 + kk) * ld + n0 + (lane & 31)]; }
    LDS_WAIT(); asm volatile("" ::: "memory");
    const int c = lane & 7;
#pragma unroll
    for (int j = 0; j < 4; ++j) { const int n = (lane >> 3) + 8 * j; const LAS float* s = scr + (8 * c) * 33 + n;
        if constexpr (F8) { u32x2 o; o.x = pk4_fp8(s[0 * 33] * W8_SCALE, s[1 * 33] * W8_SCALE, s[2 * 33] * W8_SCALE, s[3 * 33] * W8_SCALE); o.y = pk4_fp8(s[4 * 33] * W8_SCALE, s[5 * 33] * W8_SCALE, s[6 * 33] * W8_SCALE, s[7 * 33] * W8_SCALE);
            *(u32x2*)((unsigned char*)WTv + (size_t)rowmap(mode, n0 + n) * K + k0 + 8 * c) = o; }
        else { u32x4 o; o.x = pk2(s[0 * 33], s[1 * 33]); o.y = pk2(s[2 * 33], s[3 * 33]); o.z = pk2(s[4 * 33], s[5 * 33]); o.w = pk2(s[6 * 33], s[7 * 33]);
            *(u32x4*)(WT + (size_t)rowmap(mode, n0 + n) * K + k0 + 8 * c) = o; } }
    LDS_WAIT(); asm volatile("" ::: "memory");
}

__device__ __forceinline__ void p0_ssm_item(Ctx& C, const Args& a, int g, int part) {
    LAS float* pwr = (LAS float*)C.lds;
    LAS float* pwi = pwr + 65 * 64;
    LAS float* bbr = pwi + 65 * 64;
    LAS float* bbi = bbr + 1024;
    LAS float* cre = bbi + 1024;
    LAS float* cim = cre + 1024;
    const int tid = C.tid;
    __syncthreads();
    if (tid < 64) {
        const int p = tid;
        const float lr = a.in[I_LRE][g * 64 + p], li = a.in[I_LIM][g * 64 + p], dt = expf(a.in[I_LDT][g]);
        const float ar = lr * dt, ai = li * dt, mag = expf(ar);
        const float kf = rintf(ai * 0.15915494309189535f);
        float rr = fmaf(-kf, 6.28318548202514648f, ai); rr = fmaf(-kf, -1.7484555e-7f, rr);
        const float rev = rr * 0.15915494309189535f;
        const float lbr = mag * __builtin_amdgcn_cosf(rev), lbi = mag * __builtin_amdgcn_sinf(rev);
        float wr_ = 1.f, wi_ = 0.f;
        for (int tau = 0; tau <= 64; ++tau) { pwr[tau * 64 + p] = wr_; pwi[tau * 64 + p] = wi_; const float nr = wr_ * lbr - wi_ * lbi, ni = wr_ * lbi + wi_ * lbr; wr_ = nr; wi_ = ni; }
        if (part == 0) { float* lamL = (float*)(C.ws + WS_LAML); lamL[(g * 64 + p) * 2] = pwr[64 * 64 + p]; lamL[(g * 64 + p) * 2 + 1] = pwi[64 * 64 + p]; }
        const float nr = lbr - 1.f, ni = lbi, den = 1.f / (lr * lr + li * li);
        const float qr = (nr * lr + ni * li) * den, qi = (ni * lr - nr * li) * den;
        for (int c = 0; c < 16; ++c) { const float br = a.in[I_BRE][(g * 64 + p) * 16 + c], bi = a.in[I_BIM][(g * 64 + p) * 16 + c];
            bbr[p * 16 + c] = qr * br - qi * bi; bbi[p * 16 + c] = qr * bi + qi * br; }
    }
    for (int i = tid; i < 1024; i += NTHR) { cre[i] = a.in[I_CRE][g * 1024 + i]; cim[i] = a.in[I_CIM][g * 1024 + i]; }
    __syncthreads();
    if (tid < 128) {
        const int tau = 8 * part + (tid >> 4), co = tid & 15; f32x4 k0 = {0.f, 0.f, 0.f, 0.f}, k1 = k0, k2 = k0, k3 = k0;
        for (int p = 0; p < 64; ++p) { const float cr = cre[co * 64 + p], cj = cim[co * 64 + p], wr_ = pwr[tau * 64 + p], wi_ = pwi[tau * 64 + p];
            const float xr = cr * wr_ - cj * wi_, xi = cr * wi_ + cj * wr_; const LAS f32x4* br4 = (const LAS f32x4*)(bbr + p * 16); const LAS f32x4* bi4 = (const LAS f32x4*)(bbi + p * 16);
            k0 += xr * br4[0] - xi * bi4[0]; k1 += xr * br4[1] - xi * bi4[1]; k2 += xr * br4[2] - xi * bi4[2]; k3 += xr * br4[3] - xi * bi4[3]; }
        u32x4* kt = (u32x4*)(C.ws + WS_KTAB + (size_t)g * TAPS_GST + ((16 + tau) * 256 + co * 16) * 2); kt[0] = pack8(k0, k1); kt[1] = pack8(k2, k3);
    }
    if (part == 0) ((u32x4*)(C.ws + WS_KTAB + (size_t)g * TAPS_GST))[tid] = (u32x4){0u, 0u, 0u, 0u};
    bf16_t* MQT = (bf16_t*)(C.ws + WS_MQT) + (size_t)g * 1024 * AGK;
    for (int ch = tid; ch < 128 * 16; ch += NTHR) {
        const int nl = ch >> 4, kc = ch & 15, n = part * 128 + nl, t = n >> 4, co = n & 15, k0 = kc * 8; float v[8];
        const bool im = k0 >= 64; const int p0 = k0 & 63;
#pragma unroll
        for (int i = 0; i < 8; ++i) { const int p = p0 + i; const float cr = cre[co * 64 + p], cj = cim[co * 64 + p], wr_ = pwr[(t + 1) * 64 + p], wi_ = pwi[(t + 1) * 64 + p];
            v[i] = im ? -(cr * wi_ + cj * wr_) : (cr * wr_ - cj * wi_); }
        u32x4 o; o.x = pk2(v[0], v[1]); o.y = pk2(v[2], v[3]); o.z = pk2(v[4], v[5]); o.w = pk2(v[6], v[7]);
        *(u32x4*)(MQT + (size_t)n * AGK + k0) = o;
    }
    bf16_t* PT = (bf16_t*)(C.ws + WS_PT) + (size_t)g * 256 * 1024;
    for (int ch = tid; ch < 32 * 128; ch += NTHR) {
        const int nl = ch >> 7, kc = ch & 127, n = part * 32 + nl, k0 = kc * 8, j = k0 >> 4, c0 = k0 & 15; float v[8];
        if (n < 128) { const bool im = n >= 64; const int p = n & 63; const float wr_ = pwr[(63 - j) * 64 + p], wi_ = pwi[(63 - j) * 64 + p];
#pragma unroll
            for (int i = 0; i < 8; ++i) { const float br = bbr[p * 16 + c0 + i], bi = bbi[p * 16 + c0 + i]; v[i] = im ? (wr_ * bi + wi_ * br) : (wr_ * br - wi_ * bi); }
        } else {
#pragma unroll
            for (int i = 0; i < 8; ++i) v[i] = 0.f;
        }
        u32x4 o; o.x = pk2(v[0], v[1]); o.y = pk2(v[2], v[3]); o.z = pk2(v[4], v[5]); o.w = pk2(v[6], v[7]);
        *(u32x4*)(PT + (size_t)n * 1024 + k0) = o;
    }
    __syncthreads();
}
struct WTile { const float* W; unsigned char* WT; int N, mode, k0, n0; };
__device__ __forceinline__ WTile p0_wtile(const Args& a, unsigned char* ws, int tile) {
    WTile w;
    if (tile < NE * 128) { const int e = tile >> 7, r = tile & 127; w.W = a.in[I_WGU] + (size_t)e * DM * 2 * DFF; w.WT = ws + WS_WGU + (size_t)e * 2 * DFF * DM; w.N = 2 * DFF; w.mode = 2; w.k0 = (r >> 4) * 128; w.n0 = (r & 15) * 128; }
    else { tile -= NE * 128; const int e = tile >> 6, r = tile & 63; w.W = a.in[I_WD] + (size_t)e * DFF * DM; w.WT = ws + WS_WD + (size_t)e * DM * DFF; w.N = DM; w.mode = 0; w.k0 = (r >> 3) * 128; w.n0 = (r & 7) * 128; }
    return w;
}
__device__ __forceinline__ void p0_wtiles_f8(Ctx& C, const Args& a) {
    constexpr int NT = NE * 128 + NE * 64;
    LAS unsigned* img = (LAS unsigned*)C.lds;
    const int tid = C.tid, n4 = (tid & 31) * 4, kg = tid >> 5;
    f32x4 v[8]; int tile = C.vcu, buf = 0;
    if (tile >= NT) return;
    { const WTile w = p0_wtile(a, C.ws, tile);
#pragma unroll
      for (int i = 0; i < 8; ++i) v[i] = __builtin_nontemporal_load((const f32x4*)(w.W + (size_t)(w.k0 + 8 * kg + i) * w.N + w.n0 + n4)); }
    for (; tile < NT; tile += C.G, buf ^= 1) {
        const WTile w = p0_wtile(a, C.ws, tile);
        LAS unsigned* L = img + buf * (128 * 33);
#pragma unroll
        for (int h = 0; h < 2; ++h)
#pragma unroll
            for (int j = 0; j < 4; ++j) L[(n4 + j) * 33 + 2 * kg + h] = pk4_fp8(v[4 * h][j] * W8_SCALE, v[4 * h + 1][j] * W8_SCALE, v[4 * h + 2][j] * W8_SCALE, v[4 * h + 3][j] * W8_SCALE);
        __syncthreads();
        if (tile + C.G < NT) { const WTile wn = p0_wtile(a, C.ws, tile + C.G);
#pragma unroll
            for (int i = 0; i < 8; ++i) v[i] = __builtin_nontemporal_load((const f32x4*)(wn.W + (size_t)(wn.k0 + 8 * kg + i) * wn.N + wn.n0 + n4)); }
#pragma unroll
        for (int i = 0; i < 2; ++i) { const int q = tid + NTHR * i, r = q >> 3, c = q & 7; const LAS unsigned* lp = L + r * 33 + 4 * c;
            u32x4 o; o.x = lp[0]; o.y = lp[1]; o.z = lp[2]; o.w = lp[3];
            __builtin_nontemporal_store(o, (u32x4*)(w.WT + (size_t)rowmap(w.mode, w.n0 + r) * DM + w.k0 + 16 * c)); }
    }
    __syncthreads();
}

__device__ __forceinline__ void p0_prep(Ctx& C, const Args& a) { C.tid = fresh_tid(); C.lane = C.tid & 63;
    for (int it = C.vcu; it < NG * 8; it += C.G) p0_ssm_item(C, a, it >> 3, it & 7);
    __syncthreads();
    LAS float* scr = (LAS float*)(C.lds + C.wave * 16384);
    const int gw = C.vcu * NWAVES + C.wave, NGW = C.G * NWAVES;
    constexpr int I_IN = (DM / 64) * (DIN / 32), I_CO = (DC / 64) * (DM / 32), I_GL = (DS / 64) * (2 * DM / 32), I_OUT = (DM / 64) * (DM / 32);
    constexpr int NITEMS = I_IN + I_CO + I_GL + I_OUT;
    for (int it = gw; it < NITEMS; it += NGW) {
        int r = it;
        if (r < I_IN) { const int kb = r >> 7, nb = r & 127;
            if (nb < 64) p0_transpose_item(a.in[I_WIN], DM, DIN / 2, (bf16_t*)(C.ws + WS_WIN), 1, scr, kb * 64 + nb, C.lane, DIN);
            else p0_transpose_item<true>(a.in[I_WIN] + DIN / 2, DM, DIN / 2, C.ws + WS_WIN8, 0, scr, kb * 64 + (nb - 64), C.lane, DIN);
            continue; }
        r -= I_IN;
        if (r < I_CO) { p0_transpose_item(a.in[I_WCO], DC, DM, (bf16_t*)(C.ws + WS_WCO), 0, scr, r, C.lane); continue; } r -= I_CO;
        if (r < I_GL) { p0_transpose_item<true>(a.in[I_WGLU], DS, 2 * DM, C.ws + WS_WGLU, 2, scr, r, C.lane); continue; } r -= I_GL;
        p0_transpose_item(a.in[I_WOUT], DM, DM, (bf16_t*)(C.ws + WS_WOUT), 0, scr, r, C.lane);
    }
    __syncthreads();
    p0_wtiles_f8(C, a);
    { const float* wr = a.in[I_WR]; bf16_t* img = (bf16_t*)(C.ws + WS_WRIMG);
      for (int idx = C.vcu * NTHR + C.tid; idx < DM * NE; idx += C.G * NTHR) { const int d = idx >> 5, e = idx & 31; const float v = wr[idx]; const unsigned hb_ = f2bf(v); const float hf = __builtin_bit_cast(float, hb_ << 16);
          img[e * WRS + d] = (bf16_t)hb_; img[32 * WRS + e * WRS + d] = (bf16_t)f2bf(v - hf); } }
    { const float* bgu = a.in[I_BGU]; float* t32 = (float*)(C.ws + WS_BGU32);
      for (int i = C.vcu * NTHR + C.tid; i < NE * 2 * DFF; i += C.G * NTHR) t32[i] = W8_SCALE * (bgu[i] + (((i / DFF) & 1) ? 1.f : 0.f)); }
    { unsigned* ctl = (unsigned*)(C.ws + WS_CTL);
      for (int i = C.vcu * NTHR + C.tid; i < 4096 + 4096; i += C.G * NTHR) ctl[CW_CNT + i] = 0u;
      for (int i = C.vcu * NTHR + C.tid; i < T; i += C.G * NTHR) ctl[CW_RSS + i] = 0u; }
    const float* g1 = a.in[I_G1]; bf16_t* XB = (bf16_t*)(C.ws + WS_XB);
    f32x4 gv[4];
#pragma unroll
    for (int j = 0; j < 4; ++j) gv[j] = ((const f32x4*)g1)[C.lane + 64 * j];
    for (int m = gw; m < T; m += NGW) {
        const f32x4* xr = (const f32x4*)(a.in[I_X] + (size_t)m * DM) + C.lane; f32x4 v[4]; float s = 0.f;
#pragma unroll
        for (int j = 0; j < 4; ++j) { v[j] = __builtin_nontemporal_load(xr + 64 * j); s += (v[j].x * v[j].x + v[j].y * v[j].y) + (v[j].z * v[j].z + v[j].w * v[j].w); }
        const float rs = rsqrtf(wave_sum(s) * (1.f / DM) + RMS_EPS);
        u32x2* o8 = (u32x2*)(XB + (size_t)m * DM) + C.lane; unsigned* q8 = (unsigned*)(C.ws + WS_H2B + (size_t)m * DM) + C.lane;
#pragma unroll
        for (int j = 0; j < 4; ++j) { const f32x4 h = v[j] * rs * gv[j]; u32x2 w; w.x = cvt_pk_bf16(h.x, h.y); w.y = cvt_pk_bf16(h.z, h.w); o8[64 * j] = w; q8[64 * j] = pk4_fp8(h.x, h.y, h.z, h.w); }
    }
}

struct DenseOrder {
    static constexpr bool GATHER = false, TOEP = false;
    int K, ldb; const char* A; const char* B; int lda; int nM, nN, nwg, G, c;
    __device__ __forceinline__ void init(const void* A_, int lda_, const void* B_, int ldb_, int M, int N, int K_, int G_, int c_) { A = (const char*)A_; B = (const char*)B_; lda = lda_; ldb = ldb_; K = K_; nM = M / 256; nN = N / 256; nwg = nM * nN; G = G_; c = c_; }
    __device__ __forceinline__ bool next(int i, Unit& u) const {
        const long L = (long)i * G + c; if (L >= nwg) return false;
        int wgid = (int)L; { const int q = nwg / 8, r = nwg % 8, xcd = wgid % 8, off = wgid / 8; wgid = (xcd < r ? xcd * (q + 1) : r * (q + 1) + (xcd - r) * q) + off; }
        const int nig = 8 * nN, gid = wgid / nig, fm = gid * 8, gsz = (nM - fm) < 8 ? (nM - fm) : 8;
        u.pm = fm + ((wgid % nig) % gsz); u.pn = (wgid % nig) / gsz; u.e = 0; u.rb = u.pm * 256; u.nt = K / 64; return true;
    }
    __device__ __forceinline__ void addr(const Unit& u, const char*& Ap, const char*& Bp, unsigned (&avo)[2][2], const int (&R)[2], const int (&Cc)[2]) const {
        Ap = A + (size_t)u.pm * 256 * lda * 2; Bp = B + (size_t)u.pn * 256 * ldb * 2;
#pragma unroll
        for (int h = 0; h < 2; ++h)
#pragma unroll
            for (int i = 0; i < 2; ++i) avo[h][i] = (unsigned)((h * 128 + R[i]) * lda + Cc[i]) * 2u;
    }
};
struct GroupOrder {
    static constexpr bool GATHER = false, TOEP = false;
    int K, ldb; const char* A; const char* B; int lda; size_t strideA, strideB; int nM, nN, nun, G, c; bool tri;
    __device__ __forceinline__ void init(const void* A_, int lda_, size_t sA, const void* B_, int ldb_, size_t sB, int M, int N, int K_, int G_, int c_) {
        A = (const char*)A_; B = (const char*)B_; lda = lda_; ldb = ldb_; strideA = sA; strideB = sB; K = K_; nM = M / 256; nN = N / 256; nun = NG * nM * nN; G = G_; c = c_; tri = false; }
    __device__ __forceinline__ bool next(int i, Unit& u) const {
        const int L = i * G + c; if (L >= nun) return false;
        const int per = nM * nN; u.e = L / per; const int r = L % per; u.pm = r / nN; u.pn = r % nN; u.rb = u.pm * 256; u.nt = tri ? 2 + 4 * (u.pn + 1) : K / 64; return true;
    }
    __device__ __forceinline__ void addr(const Unit& u, const char*& Ap, const char*& Bp, unsigned (&avo)[2][2], const int (&R)[2], const int (&Cc)[2]) const {
        Ap = A + (size_t)u.e * strideA + (size_t)u.pm * 256 * lda * 2; Bp = B + (size_t)u.e * strideB + (size_t)u.pn * 256 * ldb * 2;
#pragma unroll
        for (int h = 0; h < 2; ++h)
#pragma unroll
            for (int i = 0; i < 2; ++i) avo[h][i] = (unsigned)((h * 128 + R[i]) * lda + Cc[i]) * 2u;
    }
};
struct ToepOrder : GroupOrder {
    static constexpr bool TOEP = true;
    const char* TB;
    __device__ __forceinline__ const char* tptr(const Unit& u) const { return TB + (size_t)u.e * TAPS_GST + 16 * 512 + u.pn * 256 * 32 - 3 * 512; }
};
struct FusedOrder {
    static constexpr bool GATHER = false, TOEP = false;
    int K, ldb, lda; const char* Ayb; const char* Aac; const char* Bglu; const char* Bco; int G, c;
    __device__ __forceinline__ bool next(int i, Unit& u) const {
        const int nM = T / 256, nN = 8, nwg = nM * nN; const long L = (long)(i >> 1) * G + c; if (L >= nwg) return false;
        int wgid = (int)L; { const int q = nwg / 8, xcd = wgid % 8, off = wgid / 8; wgid = xcd * q + off; }
        const int nig = 8 * nN, gid = wgid / nig, fm = gid * 8;
        u.pm = fm + ((wgid % nig) % 8); u.pn = (wgid % nig) / 8; u.e = 0; u.rb = u.pm * 256; u.nt = K / 64; u.mode = 1 + (i & 1); return true;
    }
    __device__ __forceinline__ void addr(const Unit& u, const char*& Ap, const char*& Bp, unsigned (&avo)[2][2], const int (&R)[2], const int (&Cc)[2]) const {
        if (u.mode == 1) { Ap = Ayb + (size_t)u.pm * 256 * lda * 2; Bp = Bglu + (size_t)u.pn * 256 * ldb * 2; }
        else { Ap = Aac + (size_t)u.pm * 256 * lda * 2; Bp = Bco + ((long)u.pn * 128 - 128) * ldb * 2; }
    }
};
struct GluOrder {
    static constexpr bool GATHER = false, TOEP = false;
    int K, ldb, lda; const char* A; const char* B; DenseOrder D;
    __device__ __forceinline__ bool next(int i, Unit& u) const { Unit d; if (!D.next(i >> 1, d)) return false; u = d; u.pn = 2 * d.pn + (i & 1); u.nt = K / 64; return true; }
    __device__ __forceinline__ void addr(const Unit& u, const char*& Ap, const char*& Bp, unsigned (&avo)[2][2], const int (&R)[2], const int (&Cc)[2]) const {
        Ap = A + (size_t)u.pm * 256 * lda * 2; Bp = B + (size_t)u.pn * 256 * ldb * 2;
#pragma unroll
        for (int h = 0; h < 2; ++h)
#pragma unroll
            for (int i = 0; i < 2; ++i) avo[h][i] = (unsigned)((h * 128 + R[i]) * lda + Cc[i]) * 2u;
    }
};
template <bool GATHER_> struct MoeOrder {
    static constexpr bool GATHER = GATHER_, TOEP = false;
    int K, ldb, lda; const char* A; const char* B; size_t strideB; int npn, G, c; const int* list; const LAS int* tstart; const LAS int* cnt;
    __device__ __forceinline__ bool next(int i, Unit& u) const {
        int panel;
        if ((G & 7) == 0 && ((G >> 3) % npn) == 0) { const int x = c & 7, j = c >> 3, ppr = G / npn; panel = i * ppr + x * (ppr >> 3) + (j / npn); u.pn = j % npn; if (panel >= tstart[NE]) return false; }
        else { const int L = i * G + c, total = tstart[NE] * npn; if (L >= total) return false; panel = L / npn; u.pn = L % npn; }
        const int e = __builtin_amdgcn_readfirstlane(tstart[192 + panel]);
        u.e = e; u.pm = panel - tstart[e]; u.rb = panel * 256; u.nt = K / 64; return true;
    }
    __device__ __forceinline__ void addr(const Unit& u, const char*& Ap, const char*& Bp, unsigned (&avo)[2][2], const int (&R)[2], const int (&Cc)[2]) const {
        Bp = B + (size_t)u.e * strideB + (size_t)u.pn * 256 * ldb * 2;
        if constexpr (GATHER_) {
            Ap = A; const int n = cnt[u.e]; const int* lp = list + (size_t)u.e * T;
#pragma unroll
            for (int h = 0; h < 2; ++h)
#pragma unroll
                for (int i = 0; i < 2; ++i) { const int idx = u.pm * 256 + h * 128 + R[i]; const int tok = idx < n ? lp[idx] : 0; avo[h][i] = (unsigned)(tok * K + Cc[i]) * 2u; }
        } else {
            Ap = A + (size_t)u.rb * lda * 2;
#pragma unroll
            for (int h = 0; h < 2; ++h)
#pragma unroll
                for (int i = 0; i < 2; ++i) avo[h][i] = (unsigned)((h * 128 + R[i]) * lda + Cc[i]) * 2u;
        }
    }
};

__device__ __forceinline__ u32x2 pack8_u8(const f32x4& a, const f32x4& b) {
    unsigned q[8];
#pragma unroll
    for (int j = 0; j < 4; ++j) { q[j] = (unsigned)(a[j] * 255.f + 0.5f); q[4 + j] = (unsigned)(b[j] * 255.f + 0.5f); }
    u32x2 w; w.x = q[0] | (q[1] << 8) | (q[2] << 16) | (q[3] << 24); w.y = q[4] | (q[5] << 8) | (q[6] << 16) | (q[7] << 24); return w;
}
__device__ __forceinline__ void unpack8_u8(const u32x2 w, f32x4& a, f32x4& b) {
#pragma unroll
    for (int j = 0; j < 4; ++j) { a[j] = (float)((w.x >> (8 * j)) & 255u) * (1.f / 255.f); b[j] = (float)((w.y >> (8 * j)) & 255u) * (1.f / 255.f); }
}
#define EPI_LOOP_AM for (int ai = 0; ai < 2; ++ai) _Pragma("unroll") for (int m = 0; m < 4; ++m)
struct EpiInProj {
    static constexpr bool PERM = true, AFTER_DRAIN = false, FUSED2 = false, WIDE = false, PREF = false, BIASINIT = false, HALFN = false;
    bf16_t *cv, *bq, *ag; unsigned char *sga, *sgb;
    __device__ __forceinline__ void operator()(const f32x4 (&acc)[2][2][4][2], const Unit& u, int wr, int wc, int fr, int fq) const {
        const int row0 = u.pm * 256 + wr * 64 + fr, cw = wc * 32 + 8 * fq, pn = u.pn;
        if (pn < 4) {
#pragma unroll
            EPI_LOOP_AM { const int row = row0 + ai * 128 + m * 16;
                *(u32x4*)(cv + (size_t)row * DC + pn * 128 + cw) = pack8(acc[ai][0][m][0] * acc[ai][1][m][0], acc[ai][0][m][1] * acc[ai][1][m][1]); }
        } else if (pn < 6) {
#pragma unroll
            EPI_LOOP_AM { const int row = row0 + ai * 128 + m * 16;
#pragma unroll
                for (int bj = 0; bj < 2; ++bj) *(u32x4*)(bq + (size_t)row * DC + (pn - 4) * 256 + bj * 128 + cw) = pack8(acc[ai][bj][m][0], acc[ai][bj][m][1]); }
        } else if (pn < 8) {
#pragma unroll
            EPI_LOOP_AM { const int row = row0 + ai * 128 + m * 16;
#pragma unroll
                for (int bj = 0; bj < 2; ++bj) { const int ch = (pn - 6) * 256 + bj * 128 + cw, g = ch >> 4, c = ch & 15;
                    *(u32x4*)(ag + ((size_t)(g * AGROWS + (row >> 6)) * AGK + AGU + (row & 63) * 16 + c)) = pack8(acc[ai][bj][m][0], acc[ai][bj][m][1]); } }
        } else {
            unsigned char* dst = pn < 12 ? sga : sgb; const int cb = ((pn - 8) & 3) * 256;
#pragma unroll
            EPI_LOOP_AM { const int row = row0 + ai * 128 + m * 16;
#pragma unroll
                for (int bj = 0; bj < 2; ++bj) *(u32x2*)(dst + (size_t)row * DM + cb + bj * 128 + cw) = pack8_u8(sigm4(acc[ai][bj][m][0]), sigm4(acc[ai][bj][m][1])); }
        }
    }
};
struct EpiGate8 {
    static constexpr bool PERM = true, AFTER_DRAIN = false, FUSED2 = false, WIDE = false, PREF = false, BIASINIT = false, HALFN = false;
    unsigned char *sga, *sgb;
    __device__ __forceinline__ void operator()(const f32x4 (&acc)[2][2][4][2], const Unit& u, int wr, int wc, int fr, int fq) const {
        const int row0 = u.pm * 256 + wr * 64 + fr, cw = wc * 32 + 8 * fq, pn = u.pn;
        unsigned char* dst = pn < 4 ? sga : sgb; const int cb = (pn & 3) * 256;
#pragma unroll
        EPI_LOOP_AM { const int row = row0 + ai * 128 + m * 16;
#pragma unroll
            for (int bj = 0; bj < 2; ++bj) *(u32x2*)(dst + (size_t)row * DM + cb + bj * 128 + cw) = pack8_u8(sigm4(acc[ai][bj][m][0] * W8_INV), sigm4(acc[ai][bj][m][1] * W8_INV)); }
    }
};
struct EpiScan {
    static constexpr bool PERM = false, AFTER_DRAIN = true, FUSED2 = false, WIDE = false, PREF = false, BIASINIT = false, HALFN = true;
    bf16_t* ag; const float* lamL;
    __device__ __forceinline__ void fused(f32x4 (&acc)[2][2][4][2], const Unit& u, int wr, int wc, int fr, int fq, LAS unsigned char* lds, int wid, int lane) const {
        LAS float* El = (LAS float*)lds;
#pragma unroll
        EPI_LOOP_AM { const int r = ai * 128 + wr * 64 + m * 16 + fr;
#pragma unroll
            for (int n = 0; n < 2; ++n) { const int chunk = (8 * wc + 4 * n + fq) ^ (r & 15); *(LAS f32x4*)(El + r * 128 + chunk * 4) = acc[ai][0][m][n]; } }
        LDS_WAIT(); __syncthreads();
        const int bl = wid, p = lane, g = u.e;
        const float lr = lamL[(g * 64 + p) * 2], li = lamL[(g * 64 + p) * 2 + 1];
        float sr = 0.f, si = 0.f;
        bf16_t* dst = ag + ((size_t)(g * AGROWS + u.pm * 256 + bl * 32)) * AGK + p;
        for (int k = 0; k < 32; ++k) {
            const int r = bl * 32 + k;
            dst[(size_t)k * AGK] = (bf16_t)f2bf(sr); dst[(size_t)k * AGK + 64] = (bf16_t)f2bf(si);
            const float er = El[r * 128 + ((((p >> 2)) ^ (r & 15)) << 2) + (p & 3)], ei = El[r * 128 + ((((p + 64) >> 2) ^ (r & 15)) << 2) + (p & 3)];
            const float nr = lr * sr - li * si + er, ni = lr * si + li * sr + ei; sr = nr; si = ni;
        }
        __syncthreads();
    }
};
struct EpiY {
    static constexpr bool PERM = true, AFTER_DRAIN = false, FUSED2 = false, WIDE = false, PREF = false, BIASINIT = false, HALFN = false;
    const bf16_t* ag; const float* dsk; unsigned char* yb;
    __device__ __forceinline__ void operator()(const f32x4 (&acc)[2][2][4][2], const Unit& u, int wr, int wc, int fr, int fq) const {
        const int g = u.e, cw = wc * 32 + 8 * fq;
#pragma unroll
        for (int bj = 0; bj < 2; ++bj) { const int col = u.pn * 256 + bj * 128 + cw, t = col >> 4, c0 = col & 15;
            const f32x4 d0 = *(const f32x4*)(dsk + g * 16 + c0), d1 = *(const f32x4*)(dsk + g * 16 + c0 + 4);
            u32x4 uv[2][4];
#pragma unroll
            EPI_LOOP_AM { const int r = u.pm * 256 + ai * 128 + wr * 64 + m * 16 + fr; uv[ai][m] = *(const u32x4*)(ag + (size_t)(g * AGROWS + r) * AGK + AGU + col); }
#pragma unroll
            EPI_LOOP_AM { const int r = u.pm * 256 + ai * 128 + wr * 64 + m * 16 + fr, b = r >> 5, chk = r & 31;
                f32x4 u0, u1; unpack8(uv[ai][m], u0, u1);
                f32x4 y0 = acc[ai][bj][m][0] + d0 * u0, y1 = acc[ai][bj][m][1] + d1 * u1;
                y0 = (f32x4){gelu_tanh(y0[0]), gelu_tanh(y0[1]), gelu_tanh(y0[2]), gelu_tanh(y0[3])}; y1 = (f32x4){gelu_tanh(y1[0]), gelu_tanh(y1[1]), gelu_tanh(y1[2]), gelu_tanh(y1[3])};
                y0 = y0 * Y8_SCALE; y1 = y1 * Y8_SCALE; u32x2 w; w.x = pk4_fp8(y0[0], y0[1], y0[2], y0[3]); w.y = pk4_fp8(y1[0], y1[1], y1[2], y1[3]);
                *(u32x2*)(yb + (size_t)(b * SEQ + chk * 64 + t) * DS + g * 16 + c0) = w; } }
    }
};
struct EpiYa {
    static constexpr bool PERM = true, AFTER_DRAIN = false, FUSED2 = false, WIDE = false, PREF = false, BIASINIT = false, HALFN = false;
    const unsigned char* sga; bf16_t* t1;
    __device__ __forceinline__ void operator()(const f32x4 (&acc)[2][2][4][2], const Unit& u, int wr, int wc, int fr, int fq) const {
        const int row0 = u.pm * 256 + wr * 64 + fr, cw = wc * 32 + 8 * fq;
        u32x2 sv[2][4];
#define EYA_LOAD(slot, b_) do { _Pragma("unroll") for (int m = 0; m < 4; ++m) sv[slot][m] = *(const u32x2*)(sga + (size_t)(row0 + ((b_) & 1) * 128 + m * 16) * DM + u.pn * 256 + ((b_) >> 1) * 128 + cw); } while (0)
        EYA_LOAD(0, 0);
#pragma unroll
        for (int b = 0; b < 4; ++b) { const int bj = b >> 1, ai = b & 1;
            if (b + 1 < 4) EYA_LOAD((b + 1) & 1, b + 1);
#pragma unroll
            for (int m = 0; m < 4; ++m) { const size_t off = (size_t)(row0 + ai * 128 + m * 16) * DM + u.pn * 256 + bj * 128 + cw; f32x4 s0, s1; unpack8_u8(sv[b & 1][m], s0, s1);
                *(u32x4*)(t1 + off) = pack8(s0 * acc[ai][bj][m][0], s1 * acc[ai][bj][m][1]); } }
#undef EYA_LOAD
    }
};
struct EpiGlu {
    static constexpr bool PERM = true, AFTER_DRAIN = false, FUSED2 = false, WIDE = false, PREF = false, BIASINIT = false, HALFN = false;
    const unsigned char* sgb; bf16_t* t1;
    __device__ __forceinline__ void operator()(const f32x4 (&acc)[2][2][4][2], const Unit& u, int wr, int wc, int fr, int fq) const {
        const int row0 = u.pm * 256 + wr * 64 + fr, cw = wc * 32 + 8 * fq;
        u32x2 sv[2][4]; u32x4 tv[2][4];
#define EGL_LOAD(slot, ai_) do { _Pragma("unroll") for (int m = 0; m < 4; ++m) { const size_t off_ = (size_t)(row0 + (ai_) * 128 + m * 16) * DM + u.pn * 128 + cw; sv[slot][m] = *(const u32x2*)(sgb + off_); tv[slot][m] = *(const u32x4*)(t1 + off_); } } while (0)
        EGL_LOAD(0, 0); EGL_LOAD(1, 1);
#pragma unroll
        EPI_LOOP_AM { const size_t off = (size_t)(row0 + ai * 128 + m * 16) * DM + u.pn * 128 + cw;
            f32x4 s0, s1, a0, a1; unpack8_u8(sv[ai][m], s0, s1); unpack8(tv[ai][m], a0, a1);
            constexpr float GI = 1.f / (Y8_SCALE * W8_SCALE);
            const f32x4 y0 = (acc[ai][0][m][0] * GI) * sigm4(acc[ai][1][m][0] * GI), y1 = (acc[ai][0][m][1] * GI) * sigm4(acc[ai][1][m][1] * GI);
            *(u32x4*)(t1 + off) = pack8(a0 + s0 * y0, a1 + s1 * y1); }
#undef EGL_LOAD
    }
};
struct EpiFused {
    static constexpr bool PERM = true, AFTER_DRAIN = false, FUSED2 = true, WIDE = false, PREF = false, BIASINIT = false, HALFN = false;
    const unsigned char* sga; const unsigned char* sgb; bf16_t* mg;
    __device__ __forceinline__ void stage(f32x4 (&acc)[2][2][4][2], const Unit& u, int wr, int wc, int fr, int fq) const {
        const int row0 = u.pm * 256 + wr * 64 + fr, cw = wc * 32 + 8 * fq; const unsigned char* gp = (u.mode == 1) ? sgb : sga;
        u32x2 sv[2][4];
#pragma unroll
        EPI_LOOP_AM { sv[ai][m] = *(const u32x2*)(gp + (size_t)(row0 + ai * 128 + m * 16) * DM + u.pn * 128 + cw); }
        if (u.mode == 1) {
#pragma unroll
            EPI_LOOP_AM { f32x4 s0, s1; unpack8_u8(sv[ai][m], s0, s1);
                acc[ai][0][m][0] = s0 * acc[ai][0][m][0] * sigm4(acc[ai][1][m][0]); acc[ai][0][m][1] = s1 * acc[ai][0][m][1] * sigm4(acc[ai][1][m][1]); }
        } else {
#pragma unroll
            EPI_LOOP_AM { f32x4 s0, s1; unpack8_u8(sv[ai][m], s0, s1);
                *(u32x4*)(mg + (size_t)(row0 + ai * 128 + m * 16) * DM + u.pn * 128 + cw) = pack8(s0 * acc[ai][1][m][0] + acc[ai][0][m][0], s1 * acc[ai][1][m][1] + acc[ai][0][m][1]); }
        }
    }
};
struct EpiOut {
    static constexpr bool PERM = true, AFTER_DRAIN = false, FUSED2 = false, WIDE = false, PREF = false, BIASINIT = false, HALFN = false;
    const float* x; bf16_t* x1b; float* rss;
    __device__ __forceinline__ void operator()(const f32x4 (&acc)[2][2][4][2], const Unit& u, int wr, int wc, int fr, int fq) const {
        const int row0 = u.pm * 256 + wr * 64 + fr, cw = wc * 32 + 8 * fq;
        f32x4 xv[3][2][2];
#define EPO_LOAD(slot, b_) do { _Pragma("unroll") for (int bj = 0; bj < 2; ++bj) { const size_t off_ = (size_t)(row0 + ((b_) >> 2) * 128 + ((b_) & 3) * 16) * DM + u.pn * 256 + bj * 128 + cw; \
            xv[slot][bj][0] = __builtin_nontemporal_load((const f32x4*)(x + off_)); xv[slot][bj][1] = __builtin_nontemporal_load((const f32x4*)(x + off_ + 4)); } } while (0)
        EPO_LOAD(0, 0); EPO_LOAD(1, 1);
#pragma unroll
        for (int b = 0; b < 8; ++b) { const int ai = b >> 2, m = b & 3;
            if (b + 2 < 8) EPO_LOAD((b + 2) % 3, b + 2);
            float ss = 0.f;
#pragma unroll
            for (int bj = 0; bj < 2; ++bj) { const size_t off = (size_t)(row0 + ai * 128 + m * 16) * DM + u.pn * 256 + bj * 128 + cw;
                const f32x4 y0 = xv[b % 3][bj][0] + acc[ai][bj][m][0], y1 = xv[b % 3][bj][1] + acc[ai][bj][m][1];
                ss += (y0[0] * y0[0] + y0[1] * y0[1]) + (y0[2] * y0[2] + y0[3] * y0[3]) + (y1[0] * y1[0] + y1[1] * y1[1]) + (y1[2] * y1[2] + y1[3] * y1[3]);
                *(u32x4*)(x1b + off) = pack8(y0, y1); }
            ss += __shfl_xor(ss, 16); ss += __shfl_xor(ss, 32);
            if (fq == 0) atomicAdd(rss + row0 + ai * 128 + m * 16, ss); }
#undef EPO_LOAD
    }
};
struct EpiGU {
    static constexpr bool PERM = true, AFTER_DRAIN = false, FUSED2 = false, WIDE = false, PREF = true, BIASINIT = true, HALFN = false;
    const float* bgu32; unsigned char* act; LAS unsigned char* lds;
    __device__ __forceinline__ void pref(const Unit& u, LAS unsigned char* l, int wid, int lane) const {
        const float* src = bgu32 + (size_t)u.e * 2 * DFF + (lane >> 5) * DFF + u.pn * 128 + (wid & 3) * 32 + (lane & 31);
        __builtin_amdgcn_global_load_lds((const unsigned*)src, (LAS unsigned*)(l + EPI_PREF_OFF + u.mode * 2048 + wid * 256), 4, 0, 0); }
    __device__ __forceinline__ void init(f32x4 (&acc)[2][2][4][2], const Unit& u, int wr, int wc, int fr, int fq) const {
        const LAS float* bp = (const LAS float*)(lds + EPI_PREF_OFF + u.mode * 2048 + (wr * 4 + wc) * 256) + 8 * fq;
        const f32x4 bg0 = *(const LAS f32x4*)(bp), bg1 = *(const LAS f32x4*)(bp + 4), bu0 = *(const LAS f32x4*)(bp + 32), bu1 = *(const LAS f32x4*)(bp + 36);
#pragma unroll
        EPI_LOOP_AM { acc[ai][0][m][0] = bg0; acc[ai][0][m][1] = bg1; acc[ai][1][m][0] = bu0; acc[ai][1][m][1] = bu1; }
    }
    __device__ __forceinline__ void operator()(const f32x4 (&acc)[2][2][4][2], const Unit& u, int wr, int wc, int fr, int fq) const {
        const int row0 = u.rb + wr * 64 + fr, cw = wc * 32 + 8 * fq, col = u.pn * 128 + cw;
        u32x2 wprev = {0u, 0u};
#pragma unroll
        EPI_LOOP_AM { const int row = row0 + ai * 128 + m * 16; f32x4 o[2];
#pragma unroll
            for (int n = 0; n < 2; ++n) { const f32x4 hg = acc[ai][0][m][n], hu = acc[ai][1][m][n];
                f32x4 gg, vv, ee, dd, rr;
#pragma unroll
                for (int j = 0; j < 4; ++j) { gg[j] = __builtin_amdgcn_fmed3f(hg[j], -3.0e38f, 7.f * W8_SCALE); vv[j] = __builtin_amdgcn_fmed3f(hu[j], -6.f * W8_SCALE, 8.f * W8_SCALE); }
                const f32x4 zz = gg * (-2.45546696f * W8_INV);
#pragma unroll
                for (int j = 0; j < 4; ++j) ee[j] = __builtin_amdgcn_exp2f(zz[j]);
#pragma unroll
                for (int j = 0; j < 4; ++j) dd[j] = __builtin_fmaf(ee[j], W8_SCALE * W8_SCALE, W8_SCALE * W8_SCALE);
#pragma unroll
                for (int j = 0; j < 4; ++j) rr[j] = __builtin_amdgcn_rcpf(dd[j]);
                const f32x4 tt = gg * rr; o[n] = tt * vv; }
            u32x2 w; w.x = pk4_fp8(o[0][0], o[0][1], o[0][2], o[0][3]); w.y = pk4_fp8(o[1][0], o[1][1], o[1][2], o[1][3]);
            if (!(m & 1)) wprev = w;
            else { const auto rx = __builtin_amdgcn_permlane16_swap(wprev.x, w.x, false, false); const auto ry = __builtin_amdgcn_permlane16_swap(wprev.y, w.y, false, false);
                u32x4 st; st.x = rx[0]; st.y = ry[0]; st.z = rx[1]; st.w = ry[1];
                *(u32x4*)(act + (size_t)(row - ((fq & 1) ? 0 : 16)) * ACT_LD + (col & ~15)) = st;
                __builtin_amdgcn_sched_barrier(0); } }
    }
};

struct EpiDown {
    static constexpr bool PERM = true, AFTER_DRAIN = false, FUSED2 = false, WIDE = true, PREF = true, BIASINIT = false, HALFN = false;
    const float* bd; unsigned char* yr; LAS unsigned char* lds;
    __device__ __forceinline__ void pref(const Unit& u, LAS unsigned char* l, int wid, int lane) const {
        const float* src = bd + (size_t)u.e * DM + u.pn * 256 + (wid & 3) * 64 + lane;
        __builtin_amdgcn_global_load_lds((const unsigned*)src, (LAS unsigned*)(l + EPI_PREF_OFF + wid * 256), 4, 0, 0); }
    __device__ __forceinline__ void operator()(const f32x4 (&acc)[2][2][4][2], const Unit& u, int wr, int wc, int fr, int fq) const {
        const int row0 = u.rb + wr * 64 + fr, col = u.pn * 256 + 16 * (4 * wc + fq);
        const LAS float* bp = (const LAS float*)(lds + EPI_PREF_OFF + (wr * 4 + wc) * 256) + 16 * fq;
        const f32x4 b0 = *(const LAS f32x4*)bp, b1 = *(const LAS f32x4*)(bp + 4), b2 = *(const LAS f32x4*)(bp + 8), b3 = *(const LAS f32x4*)(bp + 12);
#pragma unroll
        EPI_LOOP_AM { const int row = row0 + ai * 128 + m * 16;
            const f32x4 y0 = acc[ai][0][m][0] * W8_INV + b0, y1 = acc[ai][0][m][1] * W8_INV + b1, y2 = acc[ai][1][m][0] * W8_INV + b2, y3 = acc[ai][1][m][1] * W8_INV + b3;
            u32x4 w; w.x = pk4_fp8(y0[0], y0[1], y0[2], y0[3]); w.y = pk4_fp8(y1[0], y1[1], y1[2], y1[3]); w.z = pk4_fp8(y2[0], y2[1], y2[2], y2[3]); w.w = pk4_fp8(y3[0], y3[1], y3[2], y3[3]);
            *(u32x4*)(yr + (size_t)row * DM + col) = w; }
    }
};

__device__ __forceinline__ void p2_conv(Ctx& C, const Args& a, int first, int nwg) { C.tid = fresh_tid(); C.lane = C.tid & 63;
    const bf16_t* cv = (const bf16_t*)(C.ws + WS_CV); const bf16_t* bq = (const bf16_t*)(C.ws + WS_BQ); bf16_t* ac = (bf16_t*)(C.ws + WS_ACONV); const float* cw = a.in[I_CONVW];
    const int c8 = (C.tid & 63) * 8, rsub = C.tid >> 6;
    f32x4 w[3][2];
#pragma unroll
    for (int k = 0; k < 3; ++k) { w[k][0] = *(const f32x4*)(cw + k * DC + c8); w[k][1] = *(const f32x4*)(cw + k * DC + c8 + 4); }
    for (int rb0 = (C.vcu - first) * 8; rb0 < T; rb0 += nwg * 32) {
        u32x4 r0[4], r1[4], r2[4], rq[4];
#pragma unroll
        for (int u = 0; u < 4; ++u) { const int row = rb0 + u * nwg * 8 + rsub, t = row & (SEQ - 1); const size_t off = (size_t)row * DC + c8; const u32x4 z4 = {0u, 0u, 0u, 0u};
            r0[u] = z4; r1[u] = z4; r2[u] = z4; rq[u] = z4;
            if (row < T) { r0[u] = *(const u32x4*)(cv + off); rq[u] = *(const u32x4*)(bq + off);
                if (t >= 1) r1[u] = *(const u32x4*)(cv + off - DC);
                if (t >= 2) r2[u] = *(const u32x4*)(cv + off - 2 * DC); } }
#pragma unroll
        for (int u = 0; u < 4; ++u) { const int row = rb0 + u * nwg * 8 + rsub; const size_t off = (size_t)row * DC + c8;
            f32x4 h0a, h0b, h1a, h1b, h2a, h2b, ba, bb;
            unpack8(r0[u], h0a, h0b); unpack8(rq[u], ba, bb); unpack8(r1[u], h1a, h1b); unpack8(r2[u], h2a, h2b);
            const f32x4 za = w[0][0] * h2a + w[1][0] * h1a + w[2][0] * h0a, zb = w[0][1] * h2b + w[1][1] * h1b + w[2][1] * h0b;
            if (row < T) *(u32x4*)(ac + off) = pack8(ba * za, bb * zb); }
    }
}

__device__ __forceinline__ void p6_router(Ctx& C, const Args& a) { C.tid = fresh_tid(); C.lane = C.tid & 63;
    LAS bf16_t* wh = (LAS bf16_t*)C.lds;
    LAS bf16_t* wl = wh + 32 * WRS;
    LAS int* lcount = (LAS int*)(C.lds + P6X_OFF);
    LAS int* lbase = lcount + 32;
    LAS int* tk = lbase + 32;
    LAS float* g2s = (LAS float*)(tk + 512);
    const float* br = a.in[I_BR]; const float* g2 = a.in[I_G2]; const bf16_t* x1 = (const bf16_t*)(C.ws + WS_X1B);
    const float* rss = (const float*)((const unsigned*)(C.ws + WS_CTL) + CW_RSS);
    unsigned char* h2q = C.ws + WS_H2B; float* gates = (float*)(C.ws + WS_GATES); unsigned* slots = (unsigned*)(C.ws + WS_SLOTS);
    int* list = (int*)(C.ws + WS_LIST); unsigned* counts = (unsigned*)(C.ws + WS_CTL) + CW_CNT + (a.flags ? 4096 : 0);
    const int tid = C.tid, lane = C.lane, wave = C.wave, r = lane & 15, kg = lane >> 4;
    __syncthreads();
    { const unsigned char* img = C.ws + WS_WRIMG;
      for (int k = wave; k < 2 * 32 * WRS * 2 / 1024; k += NWAVES) __builtin_amdgcn_global_load_lds((const unsigned*)(img + k * 1024 + lane * 16), (LAS unsigned*)(C.lds + k * 1024), 16, 0, 0); }
    for (int i = tid; i < DM; i += NTHR) g2s[i] = g2[i];
    const float bias0 = br[r], bias1 = br[16 + r];
    for (int blk = C.vcu; blk < T / 128; blk += C.G) {
        if (tid < 32) lcount[tid] = 0;
        __syncthreads();
        const int tok_r = blk * 128 + wave * 16 + r;
        const float rs = rsqrtf(rss[tok_r] * (1.f / DM) + RMS_EPS);
        const bf16_t* xrow = x1 + (size_t)tok_r * DM + 8 * kg; unsigned char* qrow = h2q + (size_t)tok_r * DM + 8 * kg;
        f32x4 acc0 = {0.f, 0.f, 0.f, 0.f}, acc1 = acc0;
        u32x4 xw[2][8];
#pragma unroll
        for (int i = 0; i < 8; ++i) xw[0][i] = *(const u32x4*)(xrow + 32 * i);
        if (blk == C.vcu) { asm volatile("s_waitcnt vmcnt(0)" ::: "memory"); __syncthreads(); }
#pragma unroll
        for (int sb = 0; sb < 4; ++sb) { const int s8 = sb * 8;
            if (sb + 1 < 4) {
#pragma unroll
                for (int i = 0; i < 8; ++i) xw[(sb + 1) & 1][i] = *(const u32x4*)(xrow + 32 * (s8 + 8 + i)); }
#pragma unroll
            for (int i = 0; i < 8; ++i) { const int s = s8 + i;
                const f32x4 ga = *(const LAS f32x4*)(g2s + 32 * s + 8 * kg), gb = *(const LAS f32x4*)(g2s + 32 * s + 8 * kg + 4);
                f32x4 v0, v1; unpack8(xw[sb & 1][i], v0, v1); v0 = v0 * rs * ga; v1 = v1 * rs * gb;
                u32x2 q; q.x = pk4_fp8(v0[0], v0[1], v0[2], v0[3]); q.y = pk4_fp8(v1[0], v1[1], v1[2], v1[3]); *(u32x2*)(qrow + 32 * s) = q;
                const u32x4 hi = pack8(v0, v1); f32x4 h0, h1; unpack8(hi, h0, h1); const u32x4 lo = pack8(v0 - h0, v1 - h1);
                const bf16x8 ah = __builtin_bit_cast(bf16x8, hi), al = __builtin_bit_cast(bf16x8, lo);
                const bf16x8 bh0 = *(const LAS bf16x8*)(wh + r * WRS + 32 * s + 8 * kg), bh1 = *(const LAS bf16x8*)(wh + (16 + r) * WRS + 32 * s + 8 * kg);
                const bf16x8 bl0 = *(const LAS bf16x8*)(wl + r * WRS + 32 * s + 8 * kg), bl1 = *(const LAS bf16x8*)(wl + (16 + r) * WRS + 32 * s + 8 * kg);
                acc0 = __builtin_amdgcn_mfma_f32_16x16x32_bf16(ah, bh0, acc0, 0, 0, 0); acc1 = __builtin_amdgcn_mfma_f32_16x16x32_bf16(ah, bh1, acc1, 0, 0, 0);
                acc0 = __builtin_amdgcn_mfma_f32_16x16x32_bf16(al, bh0, acc0, 0, 0, 0); acc1 = __builtin_amdgcn_mfma_f32_16x16x32_bf16(al, bh1, acc1, 0, 0, 0);
                acc0 = __builtin_amdgcn_mfma_f32_16x16x32_bf16(ah, bl0, acc0, 0, 0, 0); acc1 = __builtin_amdgcn_mfma_f32_16x16x32_bf16(ah, bl1, acc1, 0, 0, 0); }
        }
#pragma unroll
        for (int reg = 0; reg < 4; ++reg) {
            float v0 = acc0[reg] + bias0, v1 = acc1[reg] + bias1;
            float tv0 = 0.f, tv1 = 0.f, tv2 = 0.f, tv3 = 0.f; int te0 = 0, te1 = 0, te2 = 0, te3 = 0;
#pragma unroll
            for (int k = 0; k < 4; ++k) {
                float mx = fmaxf(v0, v1);
#pragma unroll
                for (int o = 1; o < 16; o <<= 1) mx = fmaxf(mx, __shfl_xor(mx, o));
                const unsigned b0 = (unsigned)(__ballot(v0 == mx) >> (16 * kg)) & 0xffffu, b1 = (unsigned)(__ballot(v1 == mx) >> (16 * kg)) & 0xffffu;
                const int e = b0 ? __builtin_ctz(b0) : 16 + __builtin_ctz(b1 | 0x10000u);
                if (k == 0) { tv0 = mx; te0 = e; } else if (k == 1) { tv1 = mx; te1 = e; } else if (k == 2) { tv2 = mx; te2 = e; } else { tv3 = mx; te3 = e; }
                const bool mine = r == (e & 15);
                v0 = (mine && e < 16) ? -INFINITY : v0; v1 = (mine && e >= 16) ? -INFINITY : v1;
            }
            const float e1 = __expf(tv1 - tv0), e2 = __expf(tv2 - tv0), e3 = __expf(tv3 - tv0), inv = 1.f / (1.f + e1 + e2 + e3);
            if (r < 4) {
                const int k = r; const int e = k == 0 ? te0 : k == 1 ? te1 : k == 2 ? te2 : te3;
                const float gk = (k == 0 ? 1.f : k == 1 ? e1 : k == 2 ? e2 : e3) * inv;
                const int tl = wave * 16 + 4 * kg + reg;
                const int pl = atomicAdd((int*)&lcount[e], 1);
                tk[tl * 4 + k] = e | (pl << 8);
                gates[(size_t)(blk * 128 + tl) * 4 + k] = gk;
            }
        }
        __syncthreads();
        if (tid < 32) lbase[tid] = (int)__hip_atomic_fetch_add(counts + tid * 64, (unsigned)lcount[tid], RLX_AGENT);
        __syncthreads();
        { const int v = tk[tid], e = v & 255, pl = v >> 8, tl = tid >> 2, tok = blk * 128 + tl, pos = lbase[e] + pl;
          list[(size_t)e * T + pos] = tok; slots[(size_t)tok * 4 + (tid & 3)] = ((unsigned)e << 16) | (unsigned)pos; }
        __syncthreads();
    }
}

__device__ __forceinline__ void moe_tables(Ctx& C, LAS int* tstart, LAS int* cnt) { C.tid = fresh_tid(); C.lane = C.tid & 63;
    const unsigned* counts = (const unsigned*)(C.ws + WS_CTL) + CW_CNT;
    __syncthreads();
    if (C.tid < 32) cnt[C.tid] = (int)__hip_atomic_load(counts + C.tid * 64, RLX_AGENT);
    __syncthreads();
    if (C.tid == 0) { int s = 0; for (int e = 0; e < NE; ++e) { tstart[e] = s; s += (cnt[e] + 255) >> 8; } tstart[NE] = s; }
    __syncthreads();
    LAS int* pexp = tstart + 192;
    for (int e = 0; e < NE; ++e) for (int p = tstart[e] + C.tid; p < tstart[e + 1]; p += NTHR) pexp[p] = e;
    __syncthreads();
}

__device__ __forceinline__ void p9_combine(Ctx& C, const Args& a, const LAS int* tstart) { C.tid = fresh_tid(); C.lane = C.tid & 63;
    const unsigned char* yr = C.ws + WS_YROWS; const float* gates = (const float*)(C.ws + WS_GATES); const unsigned* slots = (const unsigned*)(C.ws + WS_SLOTS);
    float* out = a.out; const float* gf = a.in[I_GF];
    const int gw = C.vcu * NWAVES + C.wave, NGW = C.G * NWAVES, lane = C.lane;
    f32x4 gv[4];
#pragma unroll
    for (int j = 0; j < 4; ++j) gv[j] = ((const f32x4*)gf)[lane + 64 * j];
    for (int tok = gw; tok < T; tok += NGW) {
        const u32x2* xr = (const u32x2*)((const bf16_t*)(C.ws + WS_X1B) + (size_t)tok * DM) + lane; f32x4* xw = (f32x4*)(out + (size_t)tok * DM) + lane; f32x4 v[4];
#pragma unroll
        for (int j = 0; j < 4; ++j) { const u32x2 w_ = __builtin_nontemporal_load(xr + 64 * j); v[j] = (f32x4){bf_lo(w_.x), bf_hi(w_.x), bf_lo(w_.y), bf_hi(w_.y)}; }
        const u32x4 sl = *(const u32x4*)(slots + (size_t)tok * 4); const f32x4 gk = *(const f32x4*)(gates + (size_t)tok * 4);
#pragma unroll
        for (int k = 0; k < 4; ++k) { const unsigned s = sl[k]; const int e = (int)(s >> 16), pos = (int)(s & 0xffffu); const size_t row = (size_t)tstart[e] * 256 + pos;
            const unsigned* yp = (const unsigned*)(yr + row * DM) + lane;
#pragma unroll
            for (int j = 0; j < 4; ++j) { const unsigned w = __builtin_nontemporal_load(yp + 64 * j); const f32x2 lo = __builtin_amdgcn_cvt_pk_f32_fp8((int)w, false), hi = __builtin_amdgcn_cvt_pk_f32_fp8((int)w, true);
                v[j] = v[j] + gk[k] * (f32x4){lo.x, lo.y, hi.x, hi.y}; } }
        float s = 0.f;
#pragma unroll
        for (int j = 0; j < 4; ++j) s += (v[j].x * v[j].x + v[j].y * v[j].y) + (v[j].z * v[j].z + v[j].w * v[j].w);
        const float rs = rsqrtf(wave_sum(s) * (1.f / DM) + RMS_EPS);
#pragma unroll
        for (int j = 0; j < 4; ++j) __builtin_nontemporal_store(v[j] * rs * gv[j], xw + 64 * j);
    }
}


__device__ unsigned g_bar[4096];
constexpr int XB_EXIT = 3456;

constexpr int NPH = 10;
__global__ void __launch_bounds__(NTHR, 2) mk_fwd(Args args_k) {
#define args args_k
    extern __shared__ __attribute__((aligned(16))) unsigned char lds_raw[];
    Ctx C; C.lds = (LAS unsigned char*)lds_raw; C.tid = threadIdx.x; C.lane = C.tid & 63; C.wave = __builtin_amdgcn_readfirstlane(C.tid >> 6);
    C.G = gridDim.x; { const int bx = blockIdx.x; C.vcu = (C.G % 8 == 0) ? (bx % 8) * (C.G / 8) + bx / 8 : bx; }
    C.ws = args_k.ws;
    volatile LAS unsigned* MISC = (volatile LAS unsigned*)(C.lds + LCTL_OFF);
    LAS int* tstart = (LAS int*)(C.lds + LCTL_OFF + 256);
    LAS int* cnt = tstart + 40;
    for (int u = C.tid; u < (LDS_BYTES - LCTL_OFF) / 4; u += NTHR) ((LAS unsigned*)(C.lds + LCTL_OFF))[u] = 0u;
    __syncthreads();
    XcdBarrier bar; bar.bar = (unsigned*)(C.ws + WS_CTL) + CW_BAR; bar.x = 0; bar.st = nullptr;
    if (MK_N_LAUNCHES == 1) bar = xcd_barrier_post(g_bar, MISC + 8);
    const int lo = args_k.ph_lo, hi = args_k.ph_hi;
#ifndef PH_MASK
#define PH_MASK 0x3ff
#endif
#define IN(k) (((PH_MASK >> (k)) & 1) && lo <= (k) && (k) < hi)
#define SEAM(k) do { if (IN(k) && IN((k) + 1)) xcd_barrier(bar); } while (0)
    unsigned char* ws = C.ws;
    const int bid = (int)blockIdx.x;

    if (IN(0)) for (int rep = 0; rep < (PROBE_DUP == 0 ? 2 : 1); ++rep) { p0_prep(C, args); } SEAM(0);

    if (IN(1)) for (int rep = 0; rep < (PROBE_DUP == 1 ? 2 : 1); ++rep) {
        { DenseOrder S; S.init(ws + WS_XB, DM, ws + WS_WIN, DM, T, DIN / 2, DM, C.G, bid);
          EpiInProj E{(bf16_t*)(ws + WS_CV), (bf16_t*)(ws + WS_BQ), (bf16_t*)(ws + WS_AG), ws + WS_SGA, ws + WS_SGB};
          pg8::gemm_phase<EpiInProj, DenseOrder, true, true>(C.lds, S, E); }
        { DenseOrder S; S.init(ws + WS_H2B, DM / 2, ws + WS_WIN8, DM / 2, T, DIN / 2, DM / 2, C.G, bid);
          EpiGate8 E{ws + WS_SGA, ws + WS_SGB};
          pg8::gemm_phase<EpiGate8, DenseOrder, true, true, true>(C.lds, S, E); }
    } SEAM(1);

    if (IN(2)) for (int rep = 0; rep < (PROBE_DUP == 2 ? 2 : 1); ++rep) {
        GroupOrder S; S.init(ws + WS_AG + AGU * 2, AGK, (size_t)AGROWS * AGK * 2, ws + WS_PT, DM, (size_t)256 * 1024 * 2, AGROWS, 256, CL * GC, C.G, C.vcu);
        EpiScan E{(bf16_t*)(ws + WS_AG), (const float*)(ws + WS_LAML)};
        pg8::gemm_phase<EpiScan, GroupOrder, false, true>(C.lds, S, E);
        if (C.G > 64) { if (C.vcu >= 64) p2_conv(C, args, 64, C.G - 64); } else p2_conv(C, args, 0, C.G);
    } SEAM(2);

    if (IN(3)) for (int rep = 0; rep < (PROBE_DUP == 3 ? 2 : 1); ++rep) {
        { ToepOrder S; S.init(ws + WS_AG, AGK, (size_t)AGROWS * AGK * 2, ws + WS_MQT, AGK, (size_t)1024 * AGK * 2, AGROWS, CL * GC, AGK, C.G, C.vcu); S.tri = true; S.TB = (const char*)(ws + WS_KTAB);
          EpiY E{(const bf16_t*)(ws + WS_AG), args.in[I_D], ws + WS_YB};
          pg8::gemm_phase<EpiY, ToepOrder, true, true>(C.lds, S, E); }
    } SEAM(3);

    if (IN(4)) for (int rep = 0; rep < (PROBE_DUP == 4 ? 2 : 1); ++rep) {
        { DenseOrder S; S.init(ws + WS_ACONV, DS, ws + WS_WCO, DS, T, DM, DS, C.G, bid);
          EpiYa E{ws + WS_SGA, (bf16_t*)(ws + WS_T1)};
          pg8::gemm_phase<EpiYa, DenseOrder, true, true>(C.lds, S, E); }
        { GluOrder S; S.K = DS / 2; S.ldb = DS / 2; S.lda = DS / 2; S.A = (const char*)(ws + WS_YB); S.B = (const char*)(ws + WS_WGLU); S.D.init(nullptr, 0, nullptr, 0, T, DM, DS, C.G, bid);
          EpiGlu E{ws + WS_SGB, (bf16_t*)(ws + WS_T1)};
          pg8::gemm_phase<EpiGlu, GluOrder, true, true, true>(C.lds, S, E); }
    } SEAM(4);

    if (IN(5)) for (int rep = 0; rep < (PROBE_DUP == 5 ? 2 : 1); ++rep) {
        DenseOrder S; S.init(ws + WS_T1, DM, ws + WS_WOUT, DM, T, DM, DM, C.G, bid);
        EpiOut E{args.in[I_X], (bf16_t*)(ws + WS_X1B), (float*)((unsigned*)(ws + WS_CTL) + CW_RSS)};
        pg8::gemm_phase<EpiOut, DenseOrder, true, true>(C.lds, S, E);
    } SEAM(5);

    if (IN(6)) for (int rep = 0; rep < (PROBE_DUP == 6 ? 2 : 1); ++rep) { p6_router(C, args); } SEAM(6);

    if (IN(7)) for (int rep = 0; rep < (PROBE_DUP == 7 ? 2 : 1); ++rep) {
        moe_tables(C, tstart, cnt);
        MoeOrder<true> S; S.K = DM / 2; S.ldb = DM / 2; S.lda = DM / 2; S.A = (const char*)(ws + WS_H2B); S.B = (const char*)(ws + WS_WGU); S.strideB = (size_t)2 * DFF * DM; S.npn = 8; S.G = C.G; S.c = bid;
        S.list = (const int*)(ws + WS_LIST); S.tstart = tstart; S.cnt = cnt;
        EpiGU E{(const float*)(ws + WS_BGU32), ws + WS_ACT, C.lds};
        pg8::gemm_phase<EpiGU, MoeOrder<true>, true, true, true>(C.lds, S, E);
    } SEAM(7);

    if (IN(8)) for (int rep = 0; rep < (PROBE_DUP == 8 ? 2 : 1); ++rep) {
        if (MK_N_LAUNCHES != 1) moe_tables(C, tstart, cnt);
        MoeOrder<false> S; S.K = DFF / 2; S.ldb = DFF / 2; S.lda = ACT_LD / 2; S.A = (const char*)(ws + WS_ACT); S.B = (const char*)(ws + WS_WD); S.strideB = (size_t)DM * DFF; S.npn = 4; S.G = C.G; S.c = bid;
        S.list = nullptr; S.tstart = tstart; S.cnt = cnt;
        EpiDown E{args.in[I_BD], ws + WS_YROWS, C.lds};
        pg8::gemm_phase<EpiDown, MoeOrder<false>, true, true, true>(C.lds, S, E);
    } SEAM(8);

    if (IN(9)) for (int rep = 0; rep < (PROBE_DUP == 9 ? 2 : 1); ++rep) { if (MK_N_LAUNCHES != 1) moe_tables(C, tstart, cnt); p9_combine(C, args, tstart); }
    if (MK_N_LAUNCHES == 1) {
        if (threadIdx.x == 0) MISC[4] = (xb_add(&g_bar[XB_EXIT], 1u) == (unsigned)C.G - 1u) ? 1u : 0u;
        __syncthreads();
        if (MISC[4]) for (int i = threadIdx.x; i < 4096; i += NTHR) __hip_atomic_store(&g_bar[i], 0u, __ATOMIC_RELAXED, __HIP_MEMORY_SCOPE_AGENT);
    }
#undef IN
#undef SEAM
}

extern "C" void kernel_launch(void* const* d_in, const int* in_sizes, int n_in, void* d_out, int out_size, void* d_ws, size_t ws_size, hipStream_t stream) {
    static int grid = 0;
    if (grid == 0) {
        if (n_in != 23 || out_size != T * DM || ws_size < WS_END) { fprintf(stderr, "kernel_launch: unexpected problem (n_in %d, out %d, ws %zu)\n", n_in, out_size, ws_size); grid = -1; return; }
        int dev = 0, cus = 0, per_cu = 0;
        if (hipGetDevice(&dev) != hipSuccess || hipDeviceGetAttribute(&cus, hipDeviceAttributeMultiprocessorCount, dev) != hipSuccess) { grid = -1; return; }
        if (hipFuncSetAttribute((const void*)mk_fwd, hipFuncAttributeMaxDynamicSharedMemorySize, LDS_BYTES) != hipSuccess) { fprintf(stderr, "kernel_launch: hipFuncSetAttribute failed\n"); grid = -1; return; }
        if (hipOccupancyMaxActiveBlocksPerMultiprocessor(&per_cu, (const void*)mk_fwd, NTHR, LDS_BYTES) != hipSuccess || per_cu < 1) { fprintf(stderr, "kernel_launch: occupancy query says %d\n", per_cu); per_cu = 1; }
        (void)hipGetLastError();
        grid = cus * (per_cu < 1 ? per_cu : 1);
    }
    if (grid < 0) return;
    if (MK_N_LAUNCHES != 1) (void)hipMemsetAsync((char*)d_ws + WS_CTL, 0, CTL_ZERO_BYTES, stream);
    Args a{};
    for (int i = 0; i < 23; ++i) a.in[i] = (const float*)d_in[i];
    a.out = (float*)d_out; a.ws = (unsigned char*)d_ws;
    if (MK_N_LAUNCHES == 1) {
        a.ph_lo = 0; a.ph_hi = NPH;
        void* kargs[] = {&a};
        hipError_t e = hipLaunchCooperativeKernel((const void*)mk_fwd, dim3(grid), dim3(NTHR), kargs, LDS_BYTES, stream);
        if (e != hipSuccess) fprintf(stderr, "kernel_launch: cooperative launch failed: %s\n", hipGetErrorString(e));
    } else {
        for (int p = 0; p < NPH; ++p) {
            if (p == PROBE_DUP_HOST) { a.ph_lo = p; a.ph_hi = p + 1; a.flags = 1; hipLaunchKernelGGL(mk_fwd, dim3(grid), dim3(NTHR), LDS_BYTES, stream, a); a.flags = 0; }
            a.ph_lo = p; a.ph_hi = p + 1; hipLaunchKernelGGL(mk_fwd, dim3(grid), dim3(NTHR), LDS_BYTES, stream, a); }
    }
}
```

```cpp
#include <hip/hip_runtime.h>
#include <cstdio>
#include <cstdint>

#ifndef PROBE_DUP_HOST
#define PROBE_DUP_HOST -1
#endif
#ifndef PROBE_DUP
#define PROBE_DUP -1
#endif
#ifndef MK_N_LAUNCHES
#define MK_N_LAUNCHES 1
#endif

#define LAS __attribute__((address_space(3)))
#define GAS __attribute__((address_space(1)))
typedef unsigned short bf16_t;
typedef short bf16x8 __attribute__((ext_vector_type(8)));
typedef float f32x4 __attribute__((ext_vector_type(4)));
typedef float f32x2 __attribute__((ext_vector_type(2)));
typedef unsigned u32x4 __attribute__((ext_vector_type(4)));
typedef unsigned u32x2 __attribute__((ext_vector_type(2)));
typedef int i32x4 __attribute__((ext_vector_type(4)));
typedef int i32x8 __attribute__((ext_vector_type(8)));
constexpr float Y8_SCALE = 8.f;
constexpr float W8_SCALE = 32.f, W8_INV = 1.f / 32.f;

constexpr int DM = 1024, NB = 16, SEQ = 2048, T = NB * SEQ;
constexpr int DC = 512, DS = 512, NG = 32, GC = 16, NP = 64;
constexpr int DIN = 4096, NE = 32, TOPK = 4, DFF = 1024;
constexpr int CL = 64, NCH = SEQ / CL;
constexpr int AGK = CL * GC + 2 * NP;
constexpr int AGU = 2 * NP;
constexpr int AGROWS = NB * NCH;
constexpr float RMS_EPS = 1e-6f;
constexpr int TAPS_GST = 80 * 512;
constexpr int WRS = 1032;
constexpr int NWAVES = 8, NTHR = 512;
constexpr int ROWS_PAD_MAX = T * TOPK + NE * 256;
constexpr int NBF = 1536;
constexpr int ACT_LD = DFF;

constexpr size_t MiB = 1u << 20;
constexpr size_t WS_CTL = 0, CTL_ZERO_BYTES = 32768;
constexpr size_t WS_LAML = 1 * MiB;
constexpr size_t WS_GATES = 2 * MiB;
constexpr size_t WS_SLOTS = 2 * MiB + 512 * 1024;
constexpr size_t WS_WIN = 4 * MiB;
constexpr size_t WS_WIN8 = 8 * MiB;
constexpr size_t WS_WCO = 12 * MiB;
constexpr size_t WS_WGLU = 13 * MiB;
constexpr size_t WS_WOUT = 15 * MiB;
constexpr size_t WS_PT = 17 * MiB;
constexpr size_t WS_MQT = 33 * MiB;
constexpr size_t WS_LIST = 105 * MiB;
constexpr size_t WS_KTAB = 109 * MiB;
constexpr size_t WS_BGU32 = 111 * MiB;
constexpr size_t WS_WRIMG = 111 * MiB + 512 * 1024;
constexpr size_t WS_WGU = 112 * MiB;
constexpr size_t WS_WD = 240 * MiB;
constexpr size_t WS_H2B = 304 * MiB;
constexpr size_t WS_XB = 368 * MiB;
constexpr size_t WS_AG = 432 * MiB;
constexpr size_t WS_CV = 468 * MiB;
constexpr size_t WS_BQ = 500 * MiB;
constexpr size_t WS_SGA = 532 * MiB;
constexpr size_t WS_SGB = 596 * MiB;
constexpr size_t WS_ACONV = 660 * MiB;
constexpr size_t WS_YB = 692 * MiB;
constexpr size_t WS_T1 = 724 * MiB;
constexpr size_t WS_ACT = 368 * MiB;
constexpr size_t WS_YROWS = 640 * MiB;
constexpr size_t WS_X1B = 912 * MiB;
constexpr size_t WS_END = 976 * MiB;
constexpr size_t WS_OUT2 = 368 * MiB;
constexpr int CW_BAR = 4096;
constexpr int CW_CNT = 8192;
constexpr int CW_RSS = 131072;

constexpr int RING_BYTES = 131072;
constexpr int EPI_PREF_OFF = 131072;
constexpr int P6X_OFF = 132096;
constexpr int LCTL_OFF = 140 * 1024;
constexpr int LDS_BYTES = 147456;

#define LDS_WAIT() asm volatile("s_waitcnt lgkmcnt(0)" ::: "memory")
#define VM_WAIT() asm volatile("s_waitcnt vmcnt(0)" ::: "memory")
#define RLX_AGENT __ATOMIC_RELAXED, __HIP_MEMORY_SCOPE_AGENT
__device__ __forceinline__ unsigned f2bf(float f) { unsigned u = __builtin_bit_cast(unsigned, f); return (u + 0x7fffu + ((u >> 16) & 1u)) >> 16; }
__device__ __forceinline__ unsigned pk2(float lo, float hi) { return f2bf(lo) | (f2bf(hi) << 16); }
typedef __bf16 bf16x2_t __attribute__((ext_vector_type(2)));
__device__ __forceinline__ unsigned cvt_pk_bf16(float lo, float hi) { const f32x2 v = {lo, hi}; const bf16x2_t b = __builtin_convertvector(v, bf16x2_t); return __builtin_bit_cast(unsigned, b); }
__device__ __forceinline__ unsigned pk4_fp8(float a, float b, float c, float d) { int w = 0; w = __builtin_amdgcn_cvt_pk_fp8_f32(a, b, w, false); w = __builtin_amdgcn_cvt_pk_fp8_f32(c, d, w, true); return (unsigned)w; }
__device__ __forceinline__ float bf_lo(unsigned w) { return __builtin_bit_cast(float, w << 16); }
__device__ __forceinline__ float bf_hi(unsigned w) { return __builtin_bit_cast(float, w & 0xffff0000u); }
__device__ __forceinline__ float sigm(float x) { return __builtin_amdgcn_rcpf(1.f + __expf(-x)); }
__device__ __forceinline__ f32x4 sigm4(f32x4 v) { return (f32x4){sigm(v[0]), sigm(v[1]), sigm(v[2]), sigm(v[3])}; }
__device__ __forceinline__ float gelu_tanh(float x) { return x * sigm(1.5957691216f * (x + 0.044715f * x * x * x)); }
__device__ __forceinline__ u32x4 pack8(f32x4 a, f32x4 b) { u32x4 w; w.x = cvt_pk_bf16(a[0], a[1]); w.y = cvt_pk_bf16(a[2], a[3]); w.z = cvt_pk_bf16(b[0], b[1]); w.w = cvt_pk_bf16(b[2], b[3]); return w; }
__device__ __forceinline__ void unpack8(u32x4 w, f32x4& a, f32x4& b) { a = (f32x4){bf_lo(w.x), bf_hi(w.x), bf_lo(w.y), bf_hi(w.y)}; b = (f32x4){bf_lo(w.z), bf_hi(w.z), bf_lo(w.w), bf_hi(w.w)}; }
__device__ __forceinline__ float wave_sum(float v) {
#pragma unroll
    for (int o = 1; o < 64; o <<= 1) v += __shfl_xor(v, o);
    return v;
}
__device__ __forceinline__ float wave_max(float v) {
#pragma unroll
    for (int o = 1; o < 64; o <<= 1) v = fmaxf(v, __shfl_xor(v, o));
    return v;
}

__device__ __forceinline__ int fresh_tid() { int t = threadIdx.x; asm volatile("" : "+v"(t)); __builtin_assume(t >= 0 && t < 512); return t; }
namespace pg8 {
constexpr int BM = 256, BK = 64, HALF = 128, HTB = HALF * BK * 2, STAGE_BYTES = 8 * HTB;
__host__ __device__ __forceinline__ int lds_byte(int r, int c) { const int st = (r >> 4) * 2 + (c >> 5), rr = r & 15, cc = c & 31, ob = rr * 64 + cc * 2; return st * 1024 + (ob ^ (((ob >> 9) & 1) << 5)); }
__host__ __device__ __forceinline__ void stage_rc(int b, int& R, int& C) { const int st = b / 1024, sb = b % 1024, swz = sb ^ (((sb >> 9) & 1) << 5); R = (st >> 1) * 16 + swz / 64; C = (st & 1) * 32 + (swz % 64) / 2; }
__host__ __device__ __forceinline__ int perm32(int rho) { const int n = rho >> 4, i = rho & 15; return 8 * (i >> 2) + 4 * n + (i & 3); }

struct Unit { int pm, pn, e, rb, nt, mode; };

template <class Epi, class Sched, bool ALIGN_EPI, bool SP2, bool F8 = false>
__device__ __forceinline__ void gemm_phase(LAS unsigned char* lds, const Sched& S, const Epi& E) {
    const int tid = fresh_tid(), wid = __builtin_amdgcn_readfirstlane(tid >> 6), lane = tid & 63, wr = wid >> 2, wc = wid & 3, fr = lane & 15, fq = lane >> 4;
    int Rr[2], Cc[2]; unsigned voffB[2], voffA[2], voffT[2];
#pragma unroll
    for (int i = 0; i < 2; ++i) { stage_rc(tid * 16 + i * 8192, Rr[i], Cc[i]);
        const int Rb = Epi::WIDE ? (16 * (4 * (Rr[i] >> 5) + ((Rr[i] & 15) >> 2)) + 4 * ((Rr[i] >> 4) & 1) + (Rr[i] & 3)) : Epi::PERM ? ((Rr[i] & ~31) + perm32(Rr[i] & 31)) : Rr[i];
        voffB[i] = (unsigned)(Rb * S.ldb + Cc[i]) * 2u; voffA[i] = (unsigned)(Rr[i] * S.lda + Cc[i]) * 2u;
        voffT[i] = (unsigned)(Rb * 32 + (3 - (Cc[i] >> 4)) * 512 + (Cc[i] & 15) * 2); }
    const size_t hstepA = (size_t)HALF * S.lda * 2;
    const size_t kstep = (size_t)(BK * 2);
    const size_t hstepB = (size_t)(Epi::WIDE ? 8 : HALF) * S.ldb * 2;
    const unsigned ldsw = (unsigned)wid * 1024u;
    const int aoff = lds_byte(wr * 64 + fr, fq * 8), boff = lds_byte(wc * 32 + fr, fq * 8);
#define PG8_SA(b, h) (((b) * 2 + (h)) * HTB)
#define PG8_SB(b, h) ((4 + (b) * 2 + (h)) * HTB)
#define PG8_STAGE(bufoff, gbase, o0, o1) do { \
        __builtin_amdgcn_global_load_lds((const unsigned*)((const char*)(gbase) + (o0)), (LAS unsigned*)(lds + (bufoff) + ldsw), 16, 0, 0); \
        __builtin_amdgcn_global_load_lds((const unsigned*)((const char*)(gbase) + (o1)), (LAS unsigned*)(lds + (bufoff) + ldsw + 8192), 16, 0, 0); } while (0)
#define PG8_STAGE_B(bufoff, gbase) PG8_STAGE(bufoff, gbase, voffB[0], voffB[1])
#define PG8_STAGE_BT(bufoff, gbase, h) do { if constexpr (Sched::TOEP) { if (last) PG8_STAGE(bufoff, (gbase) + (h) * hstepB, voffB[0], voffB[1]); else PG8_STAGE(bufoff, (gbase) + (h) * 4096, voffT[0], voffT[1]); } \
        else PG8_STAGE(bufoff, (gbase) + (h) * hstepB, voffB[0], voffB[1]); } while (0)
#define PG8_STAGE_A(bufoff, gbase, h, o0, o1) do { if constexpr (Sched::GATHER) PG8_STAGE(bufoff, gbase, o0, o1); else PG8_STAGE(bufoff, (gbase) + (h) * hstepA, voffA[0], voffA[1]); } while (0)
#define PG8_LD8(off) __builtin_shufflevector(*(const LAS i32x4*)(lds + (off)), *(const LAS i32x4*)(lds + (off) + 1024), 0, 1, 2, 3, 4, 5, 6, 7)
#define PG8_LDA(dst, b, h) do { if constexpr (F8) { _Pragma("unroll") for (int m = 0; m < 4; ++m) dst##8[m] = PG8_LD8(PG8_SA(b, h) + aoff + m * 2048); } \
        else { _Pragma("unroll") for (int m = 0; m < 4; ++m) _Pragma("unroll") for (int k = 0; k < 2; ++k) dst[m][k] = *(const LAS bf16x8*)(lds + PG8_SA(b, h) + aoff + m * 2048 + k * 1024); } } while (0)
#define PG8_LDB(dst, b, h) do { if constexpr (F8) { _Pragma("unroll") for (int n = 0; n < 2; ++n) dst##8[n] = PG8_LD8(PG8_SB(b, h) + boff + n * 2048); } \
        else { _Pragma("unroll") for (int n = 0; n < 2; ++n) _Pragma("unroll") for (int k = 0; k < 2; ++k) dst[n][k] = *(const LAS bf16x8*)(lds + PG8_SB(b, h) + boff + n * 2048 + k * 1024); } } while (0)
#define PG8_MMA(ai, bj, At, Bt) do { __builtin_amdgcn_s_setprio(1); _Pragma("unroll") for (int m = 0; m < 4; ++m) _Pragma("unroll") for (int n = 0; n < 2; ++n) { \
        if constexpr (F8) { asm volatile("v_mfma_f32_16x16x128_f8f6f4 %0, %1, %2, %0" : "+v"(acc[ai][bj][m][n]) : "v"(Bt##8[n]), "v"(At##8[m])); } \
        else { _Pragma("unroll") for (int k = 0; k < 2; ++k) acc[ai][bj][m][n] = __builtin_amdgcn_mfma_f32_16x16x32_bf16(Bt[n][k], At[m][k], acc[ai][bj][m][n], 0, 0, 0); } } \
        __builtin_amdgcn_s_setprio(0); } while (0)
#define PG8_MMA_C(ai, bj, At, Bt) do { if constexpr (Epi::FUSED2) { if ((bj) == 1 || cur.mode != 2) PG8_MMA(ai, bj, At, Bt); } else if constexpr (Epi::HALFN) { if ((bj) == 0) PG8_MMA(ai, bj, At, Bt); } else PG8_MMA(ai, bj, At, Bt); } while (0)
#define PG8_WAIT_V(n) asm volatile("s_waitcnt vmcnt(" #n ")" ::: "memory")
#define PG8_WAIT_L(n) asm volatile("s_waitcnt lgkmcnt(" #n ")" ::: "memory")
#define PG8_BAR __builtin_amdgcn_s_barrier()
#define PG8_SCHED __builtin_amdgcn_sched_barrier(0)
    Unit cur, nxt; int ui = 0;
    if (!S.next(0, cur)) return;
    int nt = cur.nt;
    f32x4 acc[2][2][4][2];
#pragma unroll
    for (int a = 0; a < 2; ++a)
#pragma unroll
        for (int b = 0; b < 2; ++b)
#pragma unroll
            for (int m = 0; m < 4; ++m)
#pragma unroll
                for (int n = 0; n < 2; ++n) acc[a][b][m][n] = (f32x4){0.f, 0.f, 0.f, 0.f};
    if constexpr (Epi::BIASINIT) { cur.mode = 0; E.pref(cur, lds, wid, lane); asm volatile("s_waitcnt vmcnt(0)" ::: "memory"); E.init(acc, cur, wr, wc, fr, fq); }
#define PG8_ACC16(a, OP) OP(acc[a][0][0][0]), OP(acc[a][0][0][1]), OP(acc[a][0][1][0]), OP(acc[a][0][1][1]), OP(acc[a][0][2][0]), OP(acc[a][0][2][1]), OP(acc[a][0][3][0]), OP(acc[a][0][3][1]), \
                         OP(acc[a][1][0][0]), OP(acc[a][1][0][1]), OP(acc[a][1][1][0]), OP(acc[a][1][1][1]), OP(acc[a][1][2][0]), OP(acc[a][1][2][1]), OP(acc[a][1][3][0]), OP(acc[a][1][3][1])
#define PG8_PV(x) "+v"(x)
#define PG8_ACC_ANCHOR() do { if constexpr (F8) { asm volatile("" : PG8_ACC16(0, PG8_PV)); asm volatile("" : PG8_ACC16(1, PG8_PV)); } } while (0)
#define PG8_ACC_SETTLE() do { if constexpr (F8) { asm volatile("s_nop 15\n\ts_nop 15" : PG8_ACC16(0, PG8_PV)); asm volatile("s_nop 15\n\ts_nop 15" : PG8_ACC16(1, PG8_PV)); } } while (0)
    PG8_ACC_ANCHOR();
    bf16x8 At[4][2], B0[2][2], B1[2][2]; i32x8 At8[4], B08[2], B18[2];
    const char* cA; const char* cB; unsigned avo[2][2];
    S.addr(cur, cA, cB, avo, Rr, Cc);
    const char* cT = nullptr; if constexpr (Sched::TOEP) { static_assert(SP2, "TOEP needs the SP2 loop"); cT = S.tptr(cur); }
    if constexpr (SP2) {
        PG8_STAGE_B(PG8_SB(0, 0), cB); PG8_STAGE_B(PG8_SB(0, 1), cB + hstepB); PG8_STAGE_A(PG8_SA(0, 0), cA, 0, avo[0][0], avo[0][1]); PG8_STAGE_A(PG8_SA(0, 1), cA, 1, avo[1][0], avo[1][1]);
        if (wr == 1) PG8_BAR;
        PG8_WAIT_V(2); PG8_BAR;
        PG8_STAGE_B(PG8_SB(1, 0), cB + kstep); PG8_STAGE_A(PG8_SA(1, 0), cA + kstep, 0, avo[0][0], avo[0][1]); PG8_STAGE_B(PG8_SB(1, 1), cB + hstepB + kstep);
        PG8_WAIT_V(6); PG8_BAR;
    } else {
        PG8_STAGE_B(PG8_SB(0, 0), cB); PG8_STAGE_A(PG8_SA(0, 0), cA, 0, avo[0][0], avo[0][1]); PG8_STAGE_B(PG8_SB(0, 1), cB + hstepB); PG8_STAGE_A(PG8_SA(0, 1), cA, 1, avo[1][0], avo[1][1]);
        if (wr == 1) PG8_BAR;
        PG8_WAIT_V(4); PG8_BAR;
        PG8_STAGE_B(PG8_SB(1, 0), cB + kstep); PG8_STAGE_A(PG8_SA(1, 0), cA + kstep, 0, avo[0][0], avo[0][1]); PG8_STAGE_B(PG8_SB(1, 1), cB + hstepB + kstep);
        PG8_WAIT_V(6); PG8_BAR;
    }
    for (;;) {
        const bool has_next = S.next(ui + 1, nxt);
        const char* nA = cA; const char* nB = cB; unsigned navo[2][2] = {{avo[0][0], avo[0][1]}, {avo[1][0], avo[1][1]}};
        if (has_next) S.addr(nxt, nA, nB, navo, Rr, Cc);
        const char* nT = cT; if constexpr (Sched::TOEP) { if (has_next) nT = S.tptr(nxt); }
        if constexpr (Epi::BIASINIT) { nxt.mode = (ui + 1) & 1; if (has_next) E.pref(nxt, lds, wid, lane); }
        else if constexpr (Epi::PREF) { cur.mode = 0; E.pref(cur, lds, wid, lane); }
        for (int t = 0; t < nt; t += 2) {
            const bool last = (t == nt - 2);
            const char* a1 = cA + (size_t)(t + 1) * kstep;
            const char* a2 = last ? nA : cA + (size_t)(t + 2) * kstep; const char* b2 = last ? nB : (Sched::TOEP ? cT - (size_t)t * 2048 : cB + (size_t)(t + 2) * kstep);
            const char* a3 = a2 + kstep; const char* b3 = (Sched::TOEP && !last) ? b2 - 2048 : b2 + kstep;
            if constexpr (SP2) {
            PG8_LDB(B0, 0, 0); if constexpr (!Epi::HALFN) PG8_LDB(B1, 0, 1); PG8_SCHED; PG8_LDA(At, 0, 0); PG8_STAGE_A(PG8_SA(1, 1), a1, 1, avo[1][0], avo[1][1]);
            PG8_WAIT_V(8); PG8_WAIT_L(0); PG8_BAR; PG8_MMA_C(0, 0, At, B0); PG8_MMA_C(0, 1, At, B1); PG8_BAR; PG8_SCHED;
            PG8_LDA(At, 0, 1); PG8_STAGE_BT(PG8_SB(0, 0), b2, 0); PG8_STAGE_BT(PG8_SB(0, 1), b2, 1); PG8_STAGE_A(PG8_SA(0, 0), a2, 0, (last ? navo[0][0] : avo[0][0]), (last ? navo[0][1] : avo[0][1]));
            PG8_WAIT_V(8); PG8_WAIT_L(0); PG8_BAR; PG8_MMA_C(1, 0, At, B0); PG8_MMA_C(1, 1, At, B1); PG8_BAR; PG8_SCHED;
            PG8_LDB(B0, 1, 0); if constexpr (!Epi::HALFN) PG8_LDB(B1, 1, 1); PG8_SCHED; PG8_LDA(At, 1, 0); PG8_STAGE_A(PG8_SA(0, 1), a2, 1, (last ? navo[1][0] : avo[1][0]), (last ? navo[1][1] : avo[1][1]));
            PG8_WAIT_V(8); PG8_WAIT_L(0); PG8_BAR; PG8_MMA_C(0, 0, At, B0); PG8_MMA_C(0, 1, At, B1); PG8_BAR; PG8_SCHED;
            PG8_LDA(At, 1, 1); PG8_STAGE_BT(PG8_SB(1, 0), b3, 0); PG8_STAGE_BT(PG8_SB(1, 1), b3, 1); PG8_STAGE_A(PG8_SA(1, 0), a3, 0, (last ? navo[0][0] : avo[0][0]), (last ? navo[0][1] : avo[0][1]));
            PG8_WAIT_V(8); PG8_WAIT_L(0); PG8_BAR; PG8_MMA_C(1, 0, At, B0); PG8_MMA_C(1, 1, At, B1); PG8_BAR; PG8_SCHED;
            } else {
            PG8_LDB(B0, 0, 0); PG8_SCHED; PG8_LDA(At, 0, 0); PG8_STAGE_A(PG8_SA(1, 1), a1, 1, avo[1][0], avo[1][1]);
            PG8_WAIT_L(8); PG8_BAR; PG8_WAIT_L(0); PG8_MMA_C(0, 0, At, B0); PG8_BAR; PG8_SCHED;
            PG8_LDB(B1, 0, 1); PG8_STAGE_B(PG8_SB(0, 0), b2);
            PG8_BAR; PG8_WAIT_L(0); PG8_MMA_C(0, 1, At, B1); PG8_BAR;
            PG8_LDA(At, 0, 1); PG8_STAGE_A(PG8_SA(0, 0), a2, 0, (last ? navo[0][0] : avo[0][0]), (last ? navo[0][1] : avo[0][1]));
            PG8_BAR; PG8_WAIT_L(0); PG8_MMA_C(1, 0, At, B0); PG8_BAR; PG8_SCHED;
            PG8_STAGE_B(PG8_SB(0, 1), b2 + hstepB);
            PG8_WAIT_V(6); PG8_BAR; PG8_MMA_C(1, 1, At, B1); PG8_BAR;
            PG8_LDB(B0, 1, 0); PG8_SCHED; PG8_LDA(At, 1, 0); PG8_STAGE_A(PG8_SA(0, 1), a2, 1, (last ? navo[1][0] : avo[1][0]), (last ? navo[1][1] : avo[1][1]));
            PG8_WAIT_L(8); PG8_BAR; PG8_WAIT_L(0); PG8_MMA_C(0, 0, At, B0); PG8_BAR; PG8_SCHED;
            PG8_LDB(B1, 1, 1); PG8_STAGE_B(PG8_SB(1, 0), b3);
            PG8_BAR; PG8_WAIT_L(0); PG8_MMA_C(0, 1, At, B1); PG8_BAR;
            PG8_LDA(At, 1, 1); PG8_STAGE_A(PG8_SA(1, 0), a3, 0, (last ? navo[0][0] : avo[0][0]), (last ? navo[0][1] : avo[0][1]));
            PG8_BAR; PG8_WAIT_L(0); PG8_MMA_C(1, 0, At, B0); PG8_BAR; PG8_SCHED;
            PG8_STAGE_B(PG8_SB(1, 1), b3 + hstepB);
            PG8_WAIT_V(6); PG8_BAR; PG8_MMA_C(1, 1, At, B1); PG8_BAR;
            }
        }
        if constexpr (ALIGN_EPI) { if (wr == 0) PG8_BAR; }
        PG8_ACC_SETTLE();
        if constexpr (Epi::FUSED2) { E.stage(acc, cur, wr, wc, fr, fq); }
        else if constexpr (!Epi::AFTER_DRAIN) { E(acc, cur, wr, wc, fr, fq); }
        if (!has_next) break;
        const bool keep0 = Epi::FUSED2 && cur.mode == 1;
        if constexpr (Epi::BIASINIT) E.init(acc, nxt, wr, wc, fr, fq);
        else {
#pragma unroll
        for (int a = 0; a < 2; ++a)
#pragma unroll
            for (int b = 0; b < 2; ++b)
#pragma unroll
                for (int m = 0; m < 4; ++m)
#pragma unroll
                    for (int n = 0; n < 2; ++n) if (b == 1 || !keep0) acc[a][b][m][n] = (f32x4){0.f, 0.f, 0.f, 0.f};
        }
        PG8_ACC_ANCHOR();
        cur = nxt; nt = cur.nt; cA = nA; cB = nB; cT = nT; avo[0][0] = navo[0][0]; avo[0][1] = navo[0][1]; avo[1][0] = navo[1][0]; avo[1][1] = navo[1][1]; ++ui;
        if constexpr (ALIGN_EPI) { if (wr == 1) PG8_BAR; }
    }
    PG8_WAIT_V(0);
    if constexpr (!ALIGN_EPI) { if (wr == 0) PG8_BAR; }
    PG8_BAR;
    if constexpr (Epi::AFTER_DRAIN) { E.fused(acc, cur, wr, wc, fr, fq, lds, wid, lane); }
#undef PG8_SA
#undef PG8_SB
#undef PG8_STAGE
#undef PG8_STAGE_B
#undef PG8_STAGE_BT
#undef PG8_STAGE_A
#undef PG8_LDA
#undef PG8_ACC16
#undef PG8_PV
#undef PG8_ACC_ANCHOR
#undef PG8_ACC_SETTLE
#undef PG8_LD8
#undef PG8_LDB
#undef PG8_MMA
#undef PG8_MMA_C
#undef PG8_WAIT_V
#undef PG8_WAIT_L
#undef PG8_BAR
#undef PG8_SCHED
}
}
using pg8::Unit;

#define XB_TMO      128
#define XB_XCNT(j)  (256  + 64 * (j))
#define XB_XSUB(j)  (1280 + 64 * (j))
#define XB_XGEN(j)  (2304 + 64 * (j))
#define XB_TOP      3328
#define XB_TOPGEN   3392
#define XCD_BAR_WORDS 3456
#define XB_SPIN_CAP (1u << 18)
__device__ __forceinline__ unsigned xb_ld(unsigned* p)              { return __hip_atomic_load(p, __ATOMIC_RELAXED, __HIP_MEMORY_SCOPE_AGENT); }
__device__ __forceinline__ unsigned xb_add(unsigned* p, unsigned v) { return __hip_atomic_fetch_add(p, v, __ATOMIC_RELAXED, __HIP_MEMORY_SCOPE_AGENT); }
__device__ __forceinline__ unsigned xb_xcc_id() { return (unsigned)__builtin_amdgcn_s_getreg((3 << 11) | 20) & 0xFu; }
#define XB_SPIN(cond, bar) do { unsigned _sp = 0; while (cond) { __builtin_amdgcn_s_sleep(1); \
    if ((++_sp & 255u) == 0u) { if (xb_ld(&(bar)[XB_TMO])) break; if (_sp > XB_SPIN_CAP) { atomicAdd(&(bar)[XB_TMO], 1u); break; } } } } while (0)
struct XcdBarrier { unsigned* bar; unsigned x; volatile LAS unsigned* st; };
__device__ __forceinline__ XcdBarrier xcd_barrier_post(unsigned* bar, volatile LAS unsigned* st) {
    XcdBarrier b; b.bar = bar; b.x = xb_xcc_id(); b.st = st;
    if (threadIdx.x == 0) (void)xb_add(&bar[XB_XCNT(b.x)], 1u);
    return b;
}
__device__ __forceinline__ void xcd_barrier_complete(unsigned* bar, unsigned x, unsigned& nloc, unsigned& nx) {
    const unsigned G = gridDim.x * gridDim.y * gridDim.z;
    unsigned sum, cnt, mine, sp = 0u;
    for (;;) {
        sum = 0u; cnt = 0u; mine = 0u;
#pragma unroll
        for (unsigned j = 0; j < 16; ++j) { const unsigned c = xb_ld(&bar[XB_XCNT(j)]); sum += c; cnt += (c > 0u) ? 1u : 0u; mine = (j == x) ? c : mine; }
        if (sum == G) break;
        __builtin_amdgcn_s_sleep(1);
        if ((++sp & 255u) == 0u) { if (xb_ld(&bar[XB_TMO])) break; if (sp > XB_SPIN_CAP) { atomicAdd(&bar[XB_TMO], 1u); break; } }
    }
    nloc = mine > 0u ? mine : 1u; nx = cnt > 0u ? cnt : 1u;
}
__device__ __forceinline__ void xcd_barrier(const XcdBarrier& b) {
    asm volatile("s_waitcnt vmcnt(0)" ::: "memory");
    __syncthreads();
    if (threadIdx.x == 0) {
        unsigned* bar = b.bar;
        __builtin_amdgcn_s_waitcnt(0);
        unsigned nloc = b.st[0], nx = b.st[1];
        if (nloc == 0u) { xcd_barrier_complete(bar, b.x, nloc, nx); b.st[0] = nloc; b.st[1] = nx; }
        const unsigned old = xb_add(&bar[XB_XSUB(b.x)], 1u);
        const unsigned gen = old / nloc;
        if (old + 1u == (gen + 1u) * nloc) {
            __builtin_amdgcn_fence(__ATOMIC_RELEASE, "agent");
            asm volatile("s_waitcnt vmcnt(0)" ::: "memory");
            const unsigned og = xb_add(&bar[XB_TOP], 1u);
            const unsigned tg = og / nx;
            if (og + 1u == (tg + 1u) * nx) xb_add(&bar[XB_TOPGEN], 1u);
            else XB_SPIN(xb_ld(&bar[XB_TOPGEN]) == tg, bar);
            __builtin_amdgcn_fence(__ATOMIC_ACQUIRE, "agent");
            xb_add(&bar[XB_XGEN(b.x)], 1u);
            asm volatile("s_waitcnt vmcnt(0)" ::: "memory");
        } else {
            XB_SPIN(xb_ld(&bar[XB_XGEN(b.x)]) == gen, bar);
            __builtin_amdgcn_fence(__ATOMIC_ACQUIRE, "agent");
            asm volatile("s_waitcnt vmcnt(0)" ::: "memory");
        }
    }
    __syncthreads();
}

struct Args { const float* in[23]; float* out; unsigned char* ws; int ph_lo, ph_hi, flags, pad; };
typedef const __attribute__((address_space(4))) Args KArgs;
__device__ __forceinline__ const Args* fresh_args() { KArgs* p = (KArgs*)__builtin_amdgcn_kernarg_segment_ptr(); asm volatile("" : "+s"(p)); return (const Args*)p; }
enum { I_X = 0, I_G1, I_WIN, I_CONVW, I_WCO, I_LRE, I_LIM, I_LDT, I_BRE, I_BIM, I_CRE, I_CIM, I_D, I_WGLU, I_WOUT, I_G2, I_WR, I_BR, I_WGU, I_BGU, I_WD, I_BD, I_GF };

struct Ctx {
    LAS unsigned char* lds; int tid, lane, wave, G, vcu;
    unsigned char* ws;
};

__device__ __forceinline__ int rowmap(int mode, int n) {
    if (mode == 1) {
        if (n < 512) return 1024 + n;
        if (n < 1024) { const int ch = n - 512; return (ch >> 7) * 256 + (ch & 127); }
        if (n < 1536) { const int ch = n - 1024; return (ch >> 7) * 256 + 128 + (ch & 127); }
        return n;
    }
    if (mode == 2) { const int h = n >> 10, m = n & 1023; return (m >> 7) * 256 + h * 128 + (m & 127); }
    return n;
}
template <bool F8 = false>
__device__ __forceinline__ void p0_transpose_item(const float* W, int K, int N, void* WTv, int mode, LAS float* scr, int item, int lane, int ldw = 0) {
    bf16_t* WT = (bf16_t*)WTv;
    const int nblk = N / 32, kb = item / nblk, nb = item % nblk, k0 = 64 * kb, n0 = 32 * nb;
    const int ld = ldw ? ldw : N;
#pragma unroll 8
    for (int i = 0; i < 32; ++i) { const int kk = 2 * i + (lane >> 5); scr[kk * 33 + (lane & 31)] = W[(size_t)(k0 + kk) * ld + n0 + (lane & 31)]; }
    LDS_WAIT(); asm volatile("" ::: "memory");
    const int c = lane & 7;
#pragma unroll
    for (int j = 0; j < 4; ++j) { const int n = (lane >> 3) + 8 * j; const LAS float* s = scr + (8 * c) * 33 + n;
        if constexpr (F8) { u32x2 o; o.x = pk4_fp8(s[0 * 33] * W8_SCALE, s[1 * 33] * W8_SCALE, s[2 * 33] * W8_SCALE, s[3 * 33] * W8_SCALE); o.y = pk4_fp8(s[4 * 33] * W8_SCALE, s[5 * 33] * W8_SCALE, s[6 * 33] * W8_SCALE, s[7 * 33] * W8_SCALE);
            *(u32x2*)((unsigned char*)WTv + (size_t)rowmap(mode, n0 + n) * K + k0 + 8 * c) = o; }
        else { u32x4 o; o.x = pk2(s[0 * 33], s[1 * 33]); o.y = pk2(s[2 * 33], s[3 * 33]); o.z = pk2(s[4 * 33], s[5 * 33]); o.w = pk2(s[6 * 33], s[7 * 33]);
            *(u32x4*)(WT + (size_t)rowmap(mode, n0 + n) * K + k0 + 8 * c) = o; } }
    LDS_WAIT(); asm volatile("" ::: "memory");
}

__device__ __forceinline__ void p0_ssm_item(Ctx& C, const Args& a, int g, int part) {
    LAS float* pwr = (LAS float*)C.lds;
    LAS float* pwi = pwr + 65 * 64;
    LAS float* bbr = pwi + 65 * 64;
    LAS float* bbi = bbr + 1024;
    LAS float* cre = bbi + 1024;
    LAS float* cim = cre + 1024;
    const int tid = C.tid;
    __syncthreads();
    if (tid < 64) {
        const int p = tid;
        const float lr = a.in[I_LRE][g * 64 + p], li = a.in[I_LIM][g * 64 + p], dt = expf(a.in[I_LDT][g]);
        const float ar = lr * dt, ai = li * dt, mag = expf(ar);
        const float kf = rintf(ai * 0.15915494309189535f);
        float rr = fmaf(-kf, 6.28318548202514648f, ai); rr = fmaf(-kf, -1.7484555e-7f, rr);
        const float rev = rr * 0.15915494309189535f;
        const float lbr = mag * __builtin_amdgcn_cosf(rev), lbi = mag * __builtin_amdgcn_sinf(rev);
        float wr_ = 1.f, wi_ = 0.f;
        for (int tau = 0; tau <= 64; ++tau) { pwr[tau * 64 + p] = wr_; pwi[tau * 64 + p] = wi_; const float nr = wr_ * lbr - wi_ * lbi, ni = wr_ * lbi + wi_ * lbr; wr_ = nr; wi_ = ni; }
        if (part == 0) { float* lamL = (float*)(C.ws + WS_LAML); lamL[(g * 64 + p) * 2] = pwr[64 * 64 + p]; lamL[(g * 64 + p) * 2 + 1] = pwi[64 * 64 + p]; }
        const float nr = lbr - 1.f, ni = lbi, den = 1.f / (lr * lr + li * li);
        const float qr = (nr * lr + ni * li) * den, qi = (ni * lr - nr * li) * den;
        for (int c = 0; c < 16; ++c) { const float br = a.in[I_BRE][(g * 64 + p) * 16 + c], bi = a.in[I_BIM][(g * 64 + p) * 16 + c];
            bbr[p * 16 + c] = qr * br - qi * bi; bbi[p * 16 + c] = qr * bi + qi * br; }
    }
    for (int i = tid; i < 1024; i += NTHR) { cre[i] = a.in[I_CRE][g * 1024 + i]; cim[i] = a.in[I_CIM][g * 1024 + i]; }
    __syncthreads();
    if (tid < 128) {
        const int tau = 8 * part + (tid >> 4), co = tid & 15; f32x4 k0 = {0.f, 0.f, 0.f, 0.f}, k1 = k0, k2 = k0, k3 = k0;
        for (int p = 0; p < 64; ++p) { const float cr = cre[co * 64 + p], cj = cim[co * 64 + p], wr_ = pwr[tau * 64 + p], wi_ = pwi[tau * 64 + p];
            const float xr = cr * wr_ - cj * wi_, xi = cr * wi_ + cj * wr_; const LAS f32x4* br4 = (const LAS f32x4*)(bbr + p * 16); const LAS f32x4* bi4 = (const LAS f32x4*)(bbi + p * 16);
            k0 += xr * br4[0] - xi * bi4[0]; k1 += xr * br4[1] - xi * bi4[1]; k2 += xr * br4[2] - xi * bi4[2]; k3 += xr * br4[3] - xi * bi4[3]; }
        u32x4* kt = (u32x4*)(C.ws + WS_KTAB + (size_t)g * TAPS_GST + ((16 + tau) * 256 + co * 16) * 2); kt[0] = pack8(k0, k1); kt[1] = pack8(k2, k3);
    }
    if (part == 0) ((u32x4*)(C.ws + WS_KTAB + (size_t)g * TAPS_GST))[tid] = (u32x4){0u, 0u, 0u, 0u};
    bf16_t* MQT = (bf16_t*)(C.ws + WS_MQT) + (size_t)g * 1024 * AGK;
    for (int ch = tid; ch < 128 * 16; ch += NTHR) {
        const int nl = ch >> 4, kc = ch & 15, n = part * 128 + nl, t = n >> 4, co = n & 15, k0 = kc * 8; float v[8];
        const bool im = k0 >= 64; const int p0 = k0 & 63;
#pragma unroll
        for (int i = 0; i < 8; ++i) { const int p = p0 + i; const float cr = cre[co * 64 + p], cj = cim[co * 64 + p], wr_ = pwr[(t + 1) * 64 + p], wi_ = pwi[(t + 1) * 64 + p];
            v[i] = im ? -(cr * wi_ + cj * wr_) : (cr * wr_ - cj * wi_); }
        u32x4 o; o.x = pk2(v[0], v[1]); o.y = pk2(v[2], v[3]); o.z = pk2(v[4], v[5]); o.w = pk2(v[6], v[7]);
        *(u32x4*)(MQT + (size_t)n * AGK + k0) = o;
    }
    bf16_t* PT = (bf16_t*)(C.ws + WS_PT) + (size_t)g * 256 * 1024;
    for (int ch = tid; ch < 32 * 128; ch += NTHR) {
        const int nl = ch >> 7, kc = ch & 127, n = part * 32 + nl, k0 = kc * 8, j = k0 >> 4, c0 = k0 & 15; float v[8];
        if (n < 128) { const bool im = n >= 64; const int p = n & 63; const float wr_ = pwr[(63 - j) * 64 + p], wi_ = pwi[(63 - j) * 64 + p];
#pragma unroll
            for (int i = 0; i < 8; ++i) { const float br = bbr[p * 16 + c0 + i], bi = bbi[p * 16 + c0 + i]; v[i] = im ? (wr_ * bi + wi_ * br) : (wr_ * br - wi_ * bi); }
        } else {
#pragma unroll
            for (int i = 0; i < 8; ++i) v[i] = 0.f;
        }
        u32x4 o; o.x = pk2(v[0], v[1]); o.y = pk2(v[2], v[3]); o.z = pk2(v[4], v[5]); o.w = pk2(v[6], v[7]);
        *(u32x4*)(PT + (size_t)n * 1024 + k0) = o;
    }
    __syncthreads();
}
struct WTile { const float* W; unsigned char* WT; int N, mode, k0, n0; };
__device__ __forceinline__ WTile p0_wtile(const Args& a, unsigned char* ws, int tile) {
    WTile w;
    if (tile < NE * 128) { const int e = tile >> 7, r = tile & 127; w.W = a.in[I_WGU] + (size_t)e * DM * 2 * DFF; w.WT = ws + WS_WGU + (size_t)e * 2 * DFF * DM; w.N = 2 * DFF; w.mode = 2; w.k0 = (r >> 4) * 128; w.n0 = (r & 15) * 128; }
    else { tile -= NE * 128; const int e = tile >> 6, r = tile & 63; w.W = a.in[I_WD] + (size_t)e * DFF * DM; w.WT = ws + WS_WD + (size_t)e * DM * DFF; w.N = DM; w.mode = 0; w.k0 = (r >> 3) * 128; w.n0 = (r & 7) * 128; }
    return w;
}
__device__ __forceinline__ void p0_wtiles_f8(Ctx& C, const Args& a) {
    constexpr int NT = NE * 128 + NE * 64;
    LAS unsigned* img = (LAS unsigned*)C.lds;
    const int tid = C.tid, n4 = (tid & 31) * 4, kg = tid >> 5;
    f32x4 v[8]; int tile = C.vcu, buf = 0;
    if (tile >= NT) return;
    { const WTile w = p0_wtile(a, C.ws, tile);
#pragma unroll
      for (int i = 0; i < 8; ++i) v[i] = __builtin_nontemporal_load((const f32x4*)(w.W + (size_t)(w.k0 + 8 * kg + i) * w.N + w.n0 + n4)); }
    for (; tile < NT; tile += C.G, buf ^= 1) {
        const WTile w = p0_wtile(a, C.ws, tile);
        LAS unsigned* L = img + buf * (128 * 33);
#pragma unroll
        for (int h = 0; h < 2; ++h)
#pragma unroll
            for (int j = 0; j < 4; ++j) L[(n4 + j) * 33 + 2 * kg + h] = pk4_fp8(v[4 * h][j] * W8_SCALE, v[4 * h + 1][j] * W8_SCALE, v[4 * h + 2][j] * W8_SCALE, v[4 * h + 3][j] * W8_SCALE);
        __syncthreads();
        if (tile + C.G < NT) { const WTile wn = p0_wtile(a, C.ws, tile + C.G);
#pragma unroll
            for (int i = 0; i < 8; ++i) v[i] = __builtin_nontemporal_load((const f32x4*)(wn.W + (size_t)(wn.k0 + 8 * kg + i) * wn.N + wn.n0 + n4)); }
#pragma unroll
        for (int i = 0; i < 2; ++i) { const int q = tid + NTHR * i, r = q >> 3, c = q & 7; const LAS unsigned* lp = L + r * 33 + 4 * c;
            u32x4 o; o.x = lp[0]; o.y = lp[1]; o.z = lp[2]; o.w = lp[3];
            __builtin_nontemporal_store(o, (u32x4*)(w.WT + (size_t)rowmap(w.mode, w.n0 + r) * DM + w.k0 + 16 * c)); }
    }
    __syncthreads();
}

__device__ __forceinline__ void p0_prep(Ctx& C, const Args& a) { C.tid = fresh_tid(); C.lane = C.tid & 63;
    for (int it = C.vcu; it < NG * 8; it += C.G) p0_ssm_item(C, a, it >> 3, it & 7);
    __syncthreads();
    LAS float* scr = (LAS float*)(C.lds + C.wave * 16384);
    const int gw = C.vcu * NWAVES + C.wave, NGW = C.G * NWAVES;
    constexpr int I_IN = (DM / 64) * (DIN / 32), I_CO = (DC / 64) * (DM / 32), I_GL = (DS / 64) * (2 * DM / 32), I_OUT = (DM / 64) * (DM / 32);
    constexpr int NITEMS = I_IN + I_CO + I_GL + I_OUT;
    for (int it = gw; it < NITEMS; it += NGW) {
        int r = it;
        if (r < I_IN) { const int kb = r >> 7, nb = r & 127;
            if (nb < NBF / 32) p0_transpose_item(a.in[I_WIN], DM, NBF, (bf16_t*)(C.ws + WS_WIN), 1, scr, kb * (NBF / 32) + nb, C.lane, DIN);
            else p0_transpose_item<true>(a.in[I_WIN] + NBF, DM, DIN - NBF, C.ws + WS_WIN8, 0, scr, kb * ((DIN - NBF) / 32) + (nb - NBF / 32), C.lane, DIN);
            continue; }
        r -= I_IN;
        if (r < I_CO) { p0_transpose_item(a.in[I_WCO], DC, DM, (bf16_t*)(C.ws + WS_WCO), 0, scr, r, C.lane); continue; } r -= I_CO;
        if (r < I_GL) { p0_transpose_item<true>(a.in[I_WGLU], DS, 2 * DM, C.ws + WS_WGLU, 2, scr, r, C.lane); continue; } r -= I_GL;
        p0_transpose_item(a.in[I_WOUT], DM, DM, (bf16_t*)(C.ws + WS_WOUT), 0, scr, r, C.lane);
    }
    __syncthreads();
    p0_wtiles_f8(C, a);
    { const float* wr = a.in[I_WR]; bf16_t* img = (bf16_t*)(C.ws + WS_WRIMG);
      for (int idx = C.vcu * NTHR + C.tid; idx < DM * NE; idx += C.G * NTHR) { const int d = idx >> 5, e = idx & 31; const float v = wr[idx]; const unsigned hb_ = f2bf(v); const float hf = __builtin_bit_cast(float, hb_ << 16);
          img[e * WRS + d] = (bf16_t)hb_; img[32 * WRS + e * WRS + d] = (bf16_t)f2bf(v - hf); } }
    { const float* bgu = a.in[I_BGU]; float* t32 = (float*)(C.ws + WS_BGU32);
      for (int i = C.vcu * NTHR + C.tid; i < NE * 2 * DFF; i += C.G * NTHR) t32[i] = W8_SCALE * (bgu[i] + (((i / DFF) & 1) ? 1.f : 0.f)); }
    { unsigned* ctl = (unsigned*)(C.ws + WS_CTL);
      for (int i = C.vcu * NTHR + C.tid; i < 4096 + 4096; i += C.G * NTHR) ctl[CW_CNT + i] = 0u;
      for (int i = C.vcu * NTHR + C.tid; i < T; i += C.G * NTHR) ctl[CW_RSS + i] = 0u; }
    const float* g1 = a.in[I_G1]; bf16_t* XB = (bf16_t*)(C.ws + WS_XB);
    f32x4 gv[4];
#pragma unroll
    for (int j = 0; j < 4; ++j) gv[j] = ((const f32x4*)g1)[C.lane + 64 * j];
    for (int m = gw; m < T; m += NGW) {
        const f32x4* xr = (const f32x4*)(a.in[I_X] + (size_t)m * DM) + C.lane; f32x4 v[4]; float s = 0.f;
#pragma unroll
        for (int j = 0; j < 4; ++j) { v[j] = __builtin_nontemporal_load(xr + 64 * j); s += (v[j].x * v[j].x + v[j].y * v[j].y) + (v[j].z * v[j].z + v[j].w * v[j].w); }
        const float rs = rsqrtf(wave_sum(s) * (1.f / DM) + RMS_EPS);
        u32x2* o8 = (u32x2*)(XB + (size_t)m * DM) + C.lane; unsigned* q8 = (unsigned*)(C.ws + WS_H2B + (size_t)m * DM) + C.lane;
#pragma unroll
        for (int j = 0; j < 4; ++j) { const f32x4 h = v[j] * rs * gv[j]; u32x2 w; w.x = cvt_pk_bf16(h.x, h.y); w.y = cvt_pk_bf16(h.z, h.w); o8[64 * j] = w; q8[64 * j] = pk4_fp8(h.x, h.y, h.z, h.w); }
    }
}

struct DenseOrder {
    static constexpr bool GATHER = false, TOEP = false;
    int K, ldb; const char* A; const char* B; int lda; int nM, nN, nwg, G, c;
    __device__ __forceinline__ void init(const void* A_, int lda_, const void* B_, int ldb_, int M, int N, int K_, int G_, int c_) { A = (const char*)A_; B = (const char*)B_; lda = lda_; ldb = ldb_; K = K_; nM = M / 256; nN = N / 256; nwg = nM * nN; G = G_; c = c_; }
    __device__ __forceinline__ bool next(int i, Unit& u) const {
        const long L = (long)i * G + c; if (L >= nwg) return false;
        int wgid = (int)L; { const int q = nwg / 8, r = nwg % 8, xcd = wgid % 8, off = wgid / 8; wgid = (xcd < r ? xcd * (q + 1) : r * (q + 1) + (xcd - r) * q) + off; }
        const int nig = 8 * nN, gid = wgid / nig, fm = gid * 8, gsz = (nM - fm) < 8 ? (nM - fm) : 8;
        u.pm = fm + ((wgid % nig) % gsz); u.pn = (wgid % nig) / gsz; u.e = 0; u.rb = u.pm * 256; u.nt = K / 64; return true;
    }
    __device__ __forceinline__ void addr(const Unit& u, const char*& Ap, const char*& Bp, unsigned (&avo)[2][2], const int (&R)[2], const int (&Cc)[2]) const {
        Ap = A + (size_t)u.pm * 256 * lda * 2; Bp = B + (size_t)u.pn * 256 * ldb * 2;
#pragma unroll
        for (int h = 0; h < 2; ++h)
#pragma unroll
            for (int i = 0; i < 2; ++i) avo[h][i] = (unsigned)((h * 128 + R[i]) * lda + Cc[i]) * 2u;
    }
};
struct GroupOrder {
    static constexpr bool GATHER = false, TOEP = false;
    int K, ldb; const char* A; const char* B; int lda; size_t strideA, strideB; int nM, nN, nun, G, c; bool tri;
    __device__ __forceinline__ void init(const void* A_, int lda_, size_t sA, const void* B_, int ldb_, size_t sB, int M, int N, int K_, int G_, int c_) {
        A = (const char*)A_; B = (const char*)B_; lda = lda_; ldb = ldb_; strideA = sA; strideB = sB; K = K_; nM = M / 256; nN = N / 256; nun = NG * nM * nN; G = G_; c = c_; tri = false; }
    __device__ __forceinline__ bool next(int i, Unit& u) const {
        const int L = i * G + c; if (L >= nun) return false;
        const int per = nM * nN; u.e = L / per; const int r = L % per; u.pm = r / nN; u.pn = r % nN; u.rb = u.pm * 256; u.nt = tri ? 2 + 4 * (u.pn + 1) : K / 64; return true;
    }
    __device__ __forceinline__ void addr(const Unit& u, const char*& Ap, const char*& Bp, unsigned (&avo)[2][2], const int (&R)[2], const int (&Cc)[2]) const {
        Ap = A + (size_t)u.e * strideA + (size_t)u.pm * 256 * lda * 2; Bp = B + (size_t)u.e * strideB + (size_t)u.pn * 256 * ldb * 2;
#pragma unroll
        for (int h = 0; h < 2; ++h)
#pragma unroll
            for (int i = 0; i < 2; ++i) avo[h][i] = (unsigned)((h * 128 + R[i]) * lda + Cc[i]) * 2u;
    }
};
struct ToepOrder : GroupOrder {
    static constexpr bool TOEP = true;
    const char* TB;
    __device__ __forceinline__ const char* tptr(const Unit& u) const { return TB + (size_t)u.e * TAPS_GST + 16 * 512 + u.pn * 256 * 32 - 3 * 512; }
};
struct FusedOrder {
    static constexpr bool GATHER = false, TOEP = false;
    int K, ldb, lda; const char* Ayb; const char* Aac; const char* Bglu; const char* Bco; int G, c;
    __device__ __forceinline__ bool next(int i, Unit& u) const {
        const int nM = T / 256, nN = 8, nwg = nM * nN; const long L = (long)(i >> 1) * G + c; if (L >= nwg) return false;
        int wgid = (int)L; { const int q = nwg / 8, xcd = wgid % 8, off = wgid / 8; wgid = xcd * q + off; }
        const int nig = 8 * nN, gid = wgid / nig, fm = gid * 8;
        u.pm = fm + ((wgid % nig) % 8); u.pn = (wgid % nig) / 8; u.e = 0; u.rb = u.pm * 256; u.nt = K / 64; u.mode = 1 + (i & 1); return true;
    }
    __device__ __forceinline__ void addr(const Unit& u, const char*& Ap, const char*& Bp, unsigned (&avo)[2][2], const int (&R)[2], const int (&Cc)[2]) const {
        if (u.mode == 1) { Ap = Ayb + (size_t)u.pm * 256 * lda * 2; Bp = Bglu + (size_t)u.pn * 256 * ldb * 2; }
        else { Ap = Aac + (size_t)u.pm * 256 * lda * 2; Bp = Bco + ((long)u.pn * 128 - 128) * ldb * 2; }
    }
};
struct GluOrder {
    static constexpr bool GATHER = false, TOEP = false;
    int K, ldb, lda; const char* A; const char* B; DenseOrder D;
    __device__ __forceinline__ bool next(int i, Unit& u) const { Unit d; if (!D.next(i >> 1, d)) return false; u = d; u.pn = 2 * d.pn + (i & 1); u.nt = K / 64; return true; }
    __device__ __forceinline__ void addr(const Unit& u, const char*& Ap, const char*& Bp, unsigned (&avo)[2][2], const int (&R)[2], const int (&Cc)[2]) const {
        Ap = A + (size_t)u.pm * 256 * lda * 2; Bp = B + (size_t)u.pn * 256 * ldb * 2;
#pragma unroll
        for (int h = 0; h < 2; ++h)
#pragma unroll
            for (int i = 0; i < 2; ++i) avo[h][i] = (unsigned)((h * 128 + R[i]) * lda + Cc[i]) * 2u;
    }
};
template <bool GATHER_> struct MoeOrder {
    static constexpr bool GATHER = GATHER_, TOEP = false;
    int K, ldb, lda; const char* A; const char* B; size_t strideB; int npn, G, c; const int* list; const LAS int* tstart; const LAS int* cnt;
    __device__ __forceinline__ bool next(int i, Unit& u) const {
        int panel;
        if ((G & 7) == 0 && ((G >> 3) % npn) == 0) { const int x = c & 7, j = c >> 3, ppr = G / npn; panel = i * ppr + x * (ppr >> 3) + (j / npn); u.pn = j % npn; if (panel >= tstart[NE]) return false; }
        else { const int L = i * G + c, total = tstart[NE] * npn; if (L >= total) return false; panel = L / npn; u.pn = L % npn; }
        const int e = __builtin_amdgcn_readfirstlane(tstart[192 + panel]);
        u.e = e; u.pm = panel - tstart[e]; u.rb = panel * 256; u.nt = K / 64; return true;
    }
    __device__ __forceinline__ void addr(const Unit& u, const char*& Ap, const char*& Bp, unsigned (&avo)[2][2], const int (&R)[2], const int (&Cc)[2]) const {
        Bp = B + (size_t)u.e * strideB + (size_t)u.pn * 256 * ldb * 2;
        if constexpr (GATHER_) {
            Ap = A; const int n = cnt[u.e]; const int* lp = list + (size_t)u.e * T;
#pragma unroll
            for (int h = 0; h < 2; ++h)
#pragma unroll
                for (int i = 0; i < 2; ++i) { const int idx = u.pm * 256 + h * 128 + R[i]; const int tok = idx < n ? lp[idx] : 0; avo[h][i] = (unsigned)(tok * K + Cc[i]) * 2u; }
        } else {
            Ap = A + (size_t)u.rb * lda * 2;
#pragma unroll
            for (int h = 0; h < 2; ++h)
#pragma unroll
                for (int i = 0; i < 2; ++i) avo[h][i] = (unsigned)((h * 128 + R[i]) * lda + Cc[i]) * 2u;
        }
    }
};

__device__ __forceinline__ u32x2 pack8_u8(const f32x4& a, const f32x4& b) {
    unsigned q[8];
#pragma unroll
    for (int j = 0; j < 4; ++j) { q[j] = (unsigned)(a[j] * 255.f + 0.5f); q[4 + j] = (unsigned)(b[j] * 255.f + 0.5f); }
    u32x2 w; w.x = q[0] | (q[1] << 8) | (q[2] << 16) | (q[3] << 24); w.y = q[4] | (q[5] << 8) | (q[6] << 16) | (q[7] << 24); return w;
}
__device__ __forceinline__ void unpack8_u8(const u32x2 w, f32x4& a, f32x4& b) {
#pragma unroll
    for (int j = 0; j < 4; ++j) { a[j] = (float)((w.x >> (8 * j)) & 255u) * (1.f / 255.f); b[j] = (float)((w.y >> (8 * j)) & 255u) * (1.f / 255.f); }
}
#define EPI_LOOP_AM for (int ai = 0; ai < 2; ++ai) _Pragma("unroll") for (int m = 0; m < 4; ++m)
struct EpiInProj {
    static constexpr bool PERM = true, AFTER_DRAIN = false, FUSED2 = false, WIDE = false, PREF = false, BIASINIT = false, HALFN = false;
    bf16_t *cv, *bq, *ag; unsigned char *sga, *sgb;
    __device__ __forceinline__ void operator()(const f32x4 (&acc)[2][2][4][2], const Unit& u, int wr, int wc, int fr, int fq) const {
        const int row0 = u.pm * 256 + wr * 64 + fr, cw = wc * 32 + 8 * fq, pn = u.pn;
        if (pn < 4) {
#pragma unroll
            EPI_LOOP_AM { const int row = row0 + ai * 128 + m * 16;
                *(u32x4*)(cv + (size_t)row * DC + pn * 128 + cw) = pack8(acc[ai][0][m][0] * acc[ai][1][m][0], acc[ai][0][m][1] * acc[ai][1][m][1]); }
        } else if (pn < 6) {
#pragma unroll
            EPI_LOOP_AM { const int row = row0 + ai * 128 + m * 16;
#pragma unroll
                for (int bj = 0; bj < 2; ++bj) *(u32x4*)(bq + (size_t)row * DC + (pn - 4) * 256 + bj * 128 + cw) = pack8(acc[ai][bj][m][0], acc[ai][bj][m][1]); }
        } else if (pn < 8) {
#pragma unroll
            EPI_LOOP_AM { const int row = row0 + ai * 128 + m * 16;
#pragma unroll
                for (int bj = 0; bj < 2; ++bj) { const int ch = (pn - 6) * 256 + bj * 128 + cw, g = ch >> 4, c = ch & 15;
                    *(u32x4*)(ag + ((size_t)(g * AGROWS + (row >> 6)) * AGK + AGU + (row & 63) * 16 + c)) = pack8(acc[ai][bj][m][0], acc[ai][bj][m][1]); } }
        } else {
            unsigned char* dst = pn < 12 ? sga : sgb; const int cb = ((pn - 8) & 3) * 256;
#pragma unroll
            EPI_LOOP_AM { const int row = row0 + ai * 128 + m * 16;
#pragma unroll
                for (int bj = 0; bj < 2; ++bj) *(u32x2*)(dst + (size_t)row * DM + cb + bj * 128 + cw) = pack8_u8(sigm4(acc[ai][bj][m][0]), sigm4(acc[ai][bj][m][1])); }
        }
    }
};
struct EpiGate8 {
    static constexpr bool PERM = true, AFTER_DRAIN = false, FUSED2 = false, WIDE = false, PREF = false, BIASINIT = false, HALFN = false;
    unsigned char *sga, *sgb; bf16_t* ag;
    __device__ __forceinline__ void operator()(const f32x4 (&acc)[2][2][4][2], const Unit& u, int wr, int wc, int fr, int fq) const {
        const int row0 = u.pm * 256 + wr * 64 + fr, cw = wc * 32 + 8 * fq, pn = u.pn;
        if (pn < 2) {
#pragma unroll
            EPI_LOOP_AM { const int row = row0 + ai * 128 + m * 16;
#pragma unroll
                for (int bj = 0; bj < 2; ++bj) { const int ch = pn * 256 + bj * 128 + cw, g = ch >> 4, c = ch & 15;
                    *(u32x4*)(ag + ((size_t)(g * AGROWS + (row >> 6)) * AGK + AGU + (row & 63) * 16 + c)) = pack8(acc[ai][bj][m][0] * W8_INV, acc[ai][bj][m][1] * W8_INV); } }
            return; }
        unsigned char* dst = pn < 6 ? sga : sgb; const int cb = ((pn - 2) & 3) * 256;
#pragma unroll
        EPI_LOOP_AM { const int row = row0 + ai * 128 + m * 16;
#pragma unroll
            for (int bj = 0; bj < 2; ++bj) *(u32x2*)(dst + (size_t)row * DM + cb + bj * 128 + cw) = pack8_u8(sigm4(acc[ai][bj][m][0] * W8_INV), sigm4(acc[ai][bj][m][1] * W8_INV)); }
    }
};
struct EpiScan {
    static constexpr bool PERM = false, AFTER_DRAIN = true, FUSED2 = false, WIDE = false, PREF = false, BIASINIT = false, HALFN = true;
    bf16_t* ag; const float* lamL;
    __device__ __forceinline__ void fused(f32x4 (&acc)[2][2][4][2], const Unit& u, int wr, int wc, int fr, int fq, LAS unsigned char* lds, int wid, int lane) const {
        LAS float* El = (LAS float*)lds;
#pragma unroll
        EPI_LOOP_AM { const int r = ai * 128 + wr * 64 + m * 16 + fr;
#pragma unroll
            for (int n = 0; n < 2; ++n) { const int chunk = (8 * wc + 4 * n + fq) ^ (r & 15); *(LAS f32x4*)(El + r * 128 + chunk * 4) = acc[ai][0][m][n]; } }
        LDS_WAIT(); __syncthreads();
        const int bl = wid, p = lane, g = u.e;
        const float lr = lamL[(g * 64 + p) * 2], li = lamL[(g * 64 + p) * 2 + 1];
        float sr = 0.f, si = 0.f;
        bf16_t* dst = ag + ((size_t)(g * AGROWS + u.pm * 256 + bl * 32)) * AGK + p;
        for (int k = 0; k < 32; ++k) {
            const int r = bl * 32 + k;
            dst[(size_t)k * AGK] = (bf16_t)f2bf(sr); dst[(size_t)k * AGK + 64] = (bf16_t)f2bf(si);
            const float er = El[r * 128 + ((((p >> 2)) ^ (r & 15)) << 2) + (p & 3)], ei = El[r * 128 + ((((p + 64) >> 2) ^ (r & 15)) << 2) + (p & 3)];
            const float nr = lr * sr - li * si + er, ni = lr * si + li * sr + ei; sr = nr; si = ni;
        }
        __syncthreads();
    }
};
struct EpiY {
    static constexpr bool PERM = true, AFTER_DRAIN = false, FUSED2 = false, WIDE = false, PREF = false, BIASINIT = false, HALFN = false;
    const bf16_t* ag; const float* dsk; unsigned char* yb;
    __device__ __forceinline__ void operator()(const f32x4 (&acc)[2][2][4][2], const Unit& u, int wr, int wc, int fr, int fq) const {
        const int g = u.e, cw = wc * 32 + 8 * fq;
#pragma unroll
        for (int bj = 0; bj < 2; ++bj) { const int col = u.pn * 256 + bj * 128 + cw, t = col >> 4, c0 = col & 15;
            const f32x4 d0 = *(const f32x4*)(dsk + g * 16 + c0), d1 = *(const f32x4*)(dsk + g * 16 + c0 + 4);
            u32x4 uv[2][4];
#pragma unroll
            EPI_LOOP_AM { const int r = u.pm * 256 + ai * 128 + wr * 64 + m * 16 + fr; uv[ai][m] = *(const u32x4*)(ag + (size_t)(g * AGROWS + r) * AGK + AGU + col); }
#pragma unroll
            EPI_LOOP_AM { const int r = u.pm * 256 + ai * 128 + wr * 64 + m * 16 + fr, b = r >> 5, chk = r & 31;
                f32x4 u0, u1; unpack8(uv[ai][m], u0, u1);
                f32x4 y0 = acc[ai][bj][m][0] + d0 * u0, y1 = acc[ai][bj][m][1] + d1 * u1;
                y0 = (f32x4){gelu_tanh(y0[0]), gelu_tanh(y0[1]), gelu_tanh(y0[2]), gelu_tanh(y0[3])}; y1 = (f32x4){gelu_tanh(y1[0]), gelu_tanh(y1[1]), gelu_tanh(y1[2]), gelu_tanh(y1[3])};
                y0 = y0 * Y8_SCALE; y1 = y1 * Y8_SCALE; u32x2 w; w.x = pk4_fp8(y0[0], y0[1], y0[2], y0[3]); w.y = pk4_fp8(y1[0], y1[1], y1[2], y1[3]);
                *(u32x2*)(yb + (size_t)(b * SEQ + chk * 64 + t) * DS + g * 16 + c0) = w; } }
    }
};
struct EpiYa {
    static constexpr bool PERM = true, AFTER_DRAIN = false, FUSED2 = false, WIDE = false, PREF = false, BIASINIT = false, HALFN = false;
    const unsigned char* sga; bf16_t* t1;
    __device__ __forceinline__ void operator()(const f32x4 (&acc)[2][2][4][2], const Unit& u, int wr, int wc, int fr, int fq) const {
        const int row0 = u.pm * 256 + wr * 64 + fr, cw = wc * 32 + 8 * fq;
        u32x2 sv[2][4];
#define EYA_LOAD(slot, b_) do { _Pragma("unroll") for (int m = 0; m < 4; ++m) sv[slot][m] = *(const u32x2*)(sga + (size_t)(row0 + ((b_) & 1) * 128 + m * 16) * DM + u.pn * 256 + ((b_) >> 1) * 128 + cw); } while (0)
        EYA_LOAD(0, 0);
#pragma unroll
        for (int b = 0; b < 4; ++b) { const int bj = b >> 1, ai = b & 1;
            if (b + 1 < 4) EYA_LOAD((b + 1) & 1, b + 1);
#pragma unroll
            for (int m = 0; m < 4; ++m) { const size_t off = (size_t)(row0 + ai * 128 + m * 16) * DM + u.pn * 256 + bj * 128 + cw; f32x4 s0, s1; unpack8_u8(sv[b & 1][m], s0, s1);
                *(u32x4*)(t1 + off) = pack8(s0 * acc[ai][bj][m][0], s1 * acc[ai][bj][m][1]); } }
#undef EYA_LOAD
    }
};
struct EpiGlu {
    static constexpr bool PERM = true, AFTER_DRAIN = false, FUSED2 = false, WIDE = false, PREF = false, BIASINIT = false, HALFN = false;
    const unsigned char* sgb; bf16_t* t1;
    __device__ __forceinline__ void operator()(const f32x4 (&acc)[2][2][4][2], const Unit& u, int wr, int wc, int fr, int fq) const {
        const int row0 = u.pm * 256 + wr * 64 + fr, cw = wc * 32 + 8 * fq;
        u32x2 sv[2][4]; u32x4 tv[2][4];
#define EGL_LOAD(slot, ai_) do { _Pragma("unroll") for (int m = 0; m < 4; ++m) { const size_t off_ = (size_t)(row0 + (ai_) * 128 + m * 16) * DM + u.pn * 128 + cw; sv[slot][m] = *(const u32x2*)(sgb + off_); tv[slot][m] = *(const u32x4*)(t1 + off_); } } while (0)
        EGL_LOAD(0, 0); EGL_LOAD(1, 1);
#pragma unroll
        EPI_LOOP_AM { const size_t off = (size_t)(row0 + ai * 128 + m * 16) * DM + u.pn * 128 + cw;
            f32x4 s0, s1, a0, a1; unpack8_u8(sv[ai][m], s0, s1); unpack8(tv[ai][m], a0, a1);
            constexpr float GI = 1.f / (Y8_SCALE * W8_SCALE);
            const f32x4 y0 = (acc[ai][0][m][0] * GI) * sigm4(acc[ai][1][m][0] * GI), y1 = (acc[ai][0][m][1] * GI) * sigm4(acc[ai][1][m][1] * GI);
            *(u32x4*)(t1 + off) = pack8(a0 + s0 * y0, a1 + s1 * y1); }
#undef EGL_LOAD
    }
};
struct EpiFused {
    static constexpr bool PERM = true, AFTER_DRAIN = false, FUSED2 = true, WIDE = false, PREF = false, BIASINIT = false, HALFN = false;
    const unsigned char* sga; const unsigned char* sgb; bf16_t* mg;
    __device__ __forceinline__ void stage(f32x4 (&acc)[2][2][4][2], const Unit& u, int wr, int wc, int fr, int fq) const {
        const int row0 = u.pm * 256 + wr * 64 + fr, cw = wc * 32 + 8 * fq; const unsigned char* gp = (u.mode == 1) ? sgb : sga;
        u32x2 sv[2][4];
#pragma unroll
        EPI_LOOP_AM { sv[ai][m] = *(const u32x2*)(gp + (size_t)(row0 + ai * 128 + m * 16) * DM + u.pn * 128 + cw); }
        if (u.mode == 1) {
#pragma unroll
            EPI_LOOP_AM { f32x4 s0, s1; unpack8_u8(sv[ai][m], s0, s1);
                acc[ai][0][m][0] = s0 * acc[ai][0][m][0] * sigm4(acc[ai][1][m][0]); acc[ai][0][m][1] = s1 * acc[ai][0][m][1] * sigm4(acc[ai][1][m][1]); }
        } else {
#pragma unroll
            EPI_LOOP_AM { f32x4 s0, s1; unpack8_u8(sv[ai][m], s0, s1);
                *(u32x4*)(mg + (size_t)(row0 + ai * 128 + m * 16) * DM + u.pn * 128 + cw) = pack8(s0 * acc[ai][1][m][0] + acc[ai][0][m][0], s1 * acc[ai][1][m][1] + acc[ai][0][m][1]); }
        }
    }
};
struct EpiOut {
    static constexpr bool PERM = true, AFTER_DRAIN = false, FUSED2 = false, WIDE = false, PREF = false, BIASINIT = false, HALFN = false;
    const float* x; bf16_t* x1b; float* rss;
    __device__ __forceinline__ void operator()(const f32x4 (&acc)[2][2][4][2], const Unit& u, int wr, int wc, int fr, int fq) const {
        const int row0 = u.pm * 256 + wr * 64 + fr, cw = wc * 32 + 8 * fq;
        f32x4 xv[3][2][2];
#define EPO_LOAD(slot, b_) do { _Pragma("unroll") for (int bj = 0; bj < 2; ++bj) { const size_t off_ = (size_t)(row0 + ((b_) >> 2) * 128 + ((b_) & 3) * 16) * DM + u.pn * 256 + bj * 128 + cw; \
            xv[slot][bj][0] = __builtin_nontemporal_load((const f32x4*)(x + off_)); xv[slot][bj][1] = __builtin_nontemporal_load((const f32x4*)(x + off_ + 4)); } } while (0)
        EPO_LOAD(0, 0); EPO_LOAD(1, 1);
#pragma unroll
        for (int b = 0; b < 8; ++b) { const int ai = b >> 2, m = b & 3;
            if (b + 2 < 8) EPO_LOAD((b + 2) % 3, b + 2);
            float ss = 0.f;
#pragma unroll
            for (int bj = 0; bj < 2; ++bj) { const size_t off = (size_t)(row0 + ai * 128 + m * 16) * DM + u.pn * 256 + bj * 128 + cw;
                const f32x4 y0 = xv[b % 3][bj][0] + acc[ai][bj][m][0], y1 = xv[b % 3][bj][1] + acc[ai][bj][m][1];
                ss += (y0[0] * y0[0] + y0[1] * y0[1]) + (y0[2] * y0[2] + y0[3] * y0[3]) + (y1[0] * y1[0] + y1[1] * y1[1]) + (y1[2] * y1[2] + y1[3] * y1[3]);
                *(u32x4*)(x1b + off) = pack8(y0, y1); }
            ss += __shfl_xor(ss, 16); ss += __shfl_xor(ss, 32);
            if (fq == 0) atomicAdd(rss + row0 + ai * 128 + m * 16, ss); }
#undef EPO_LOAD
    }
};
struct EpiGU {
    static constexpr bool PERM = true, AFTER_DRAIN = false, FUSED2 = false, WIDE = false, PREF = true, BIASINIT = true, HALFN = false;
    const float* bgu32; unsigned char* act; LAS unsigned char* lds;
    __device__ __forceinline__ void pref(const Unit& u, LAS unsigned char* l, int wid, int lane) const {
        const float* src = bgu32 + (size_t)u.e * 2 * DFF + (lane >> 5) * DFF + u.pn * 128 + (wid & 3) * 32 + (lane & 31);
        __builtin_amdgcn_global_load_lds((const unsigned*)src, (LAS unsigned*)(l + EPI_PREF_OFF + u.mode * 2048 + wid * 256), 4, 0, 0); }
    __device__ __forceinline__ void init(f32x4 (&acc)[2][2][4][2], const Unit& u, int wr, int wc, int fr, int fq) const {
        const LAS float* bp = (const LAS float*)(lds + EPI_PREF_OFF + u.mode * 2048 + (wr * 4 + wc) * 256) + 8 * fq;
        const f32x4 bg0 = *(const LAS f32x4*)(bp), bg1 = *(const LAS f32x4*)(bp + 4), bu0 = *(const LAS f32x4*)(bp + 32), bu1 = *(const LAS f32x4*)(bp + 36);
#pragma unroll
        EPI_LOOP_AM { acc[ai][0][m][0] = bg0; acc[ai][0][m][1] = bg1; acc[ai][1][m][0] = bu0; acc[ai][1][m][1] = bu1; }
    }
    __device__ __forceinline__ void operator()(const f32x4 (&acc)[2][2][4][2], const Unit& u, int wr, int wc, int fr, int fq) const {
        const int row0 = u.rb + wr * 64 + fr, cw = wc * 32 + 8 * fq, col = u.pn * 128 + cw;
        u32x2 wprev = {0u, 0u};
#pragma unroll
        EPI_LOOP_AM { const int row = row0 + ai * 128 + m * 16; f32x4 o[2];
#pragma unroll
            for (int n = 0; n < 2; ++n) { const f32x4 hg = acc[ai][0][m][n], hu = acc[ai][1][m][n];
                f32x4 gg, vv, ee, dd, rr;
#pragma unroll
                for (int j = 0; j < 4; ++j) { gg[j] = __builtin_amdgcn_fmed3f(hg[j], -3.0e38f, 7.f * W8_SCALE); vv[j] = __builtin_amdgcn_fmed3f(hu[j], -6.f * W8_SCALE, 8.f * W8_SCALE); }
                const f32x4 zz = gg * (-2.45546696f * W8_INV);
#pragma unroll
                for (int j = 0; j < 4; ++j) ee[j] = __builtin_amdgcn_exp2f(zz[j]);
#pragma unroll
                for (int j = 0; j < 4; ++j) dd[j] = __builtin_fmaf(ee[j], W8_SCALE * W8_SCALE, W8_SCALE * W8_SCALE);
#pragma unroll
                for (int j = 0; j < 4; ++j) rr[j] = __builtin_amdgcn_rcpf(dd[j]);
                const f32x4 tt = gg * rr; o[n] = tt * vv; }
            u32x2 w; w.x = pk4_fp8(o[0][0], o[0][1], o[0][2], o[0][3]); w.y = pk4_fp8(o[1][0], o[1][1], o[1][2], o[1][3]);
            if (!(m & 1)) wprev = w;
            else { const auto rx = __builtin_amdgcn_permlane16_swap(wprev.x, w.x, false, false); const auto ry = __builtin_amdgcn_permlane16_swap(wprev.y, w.y, false, false);
                u32x4 st; st.x = rx[0]; st.y = ry[0]; st.z = rx[1]; st.w = ry[1];
                *(u32x4*)(act + (size_t)(row - ((fq & 1) ? 0 : 16)) * ACT_LD + (col & ~15)) = st;
                __builtin_amdgcn_sched_barrier(0); } }
    }
};

struct EpiDown {
    static constexpr bool PERM = true, AFTER_DRAIN = false, FUSED2 = false, WIDE = true, PREF = true, BIASINIT = false, HALFN = false;
    const float* bd; unsigned char* yr; LAS unsigned char* lds;
    __device__ __forceinline__ void pref(const Unit& u, LAS unsigned char* l, int wid, int lane) const {
        const float* src = bd + (size_t)u.e * DM + u.pn * 256 + (wid & 3) * 64 + lane;
        __builtin_amdgcn_global_load_lds((const unsigned*)src, (LAS unsigned*)(l + EPI_PREF_OFF + wid * 256), 4, 0, 0); }
    __device__ __forceinline__ void operator()(const f32x4 (&acc)[2][2][4][2], const Unit& u, int wr, int wc, int fr, int fq) const {
        const int row0 = u.rb + wr * 64 + fr, col = u.pn * 256 + 16 * (4 * wc + fq);
        const LAS float* bp = (const LAS float*)(lds + EPI_PREF_OFF + (wr * 4 + wc) * 256) + 16 * fq;
        const f32x4 b0 = *(const LAS f32x4*)bp, b1 = *(const LAS f32x4*)(bp + 4), b2 = *(const LAS f32x4*)(bp + 8), b3 = *(const LAS f32x4*)(bp + 12);
#pragma unroll
        EPI_LOOP_AM { const int row = row0 + ai * 128 + m * 16;
            const f32x4 y0 = acc[ai][0][m][0] * W8_INV + b0, y1 = acc[ai][0][m][1] * W8_INV + b1, y2 = acc[ai][1][m][0] * W8_INV + b2, y3 = acc[ai][1][m][1] * W8_INV + b3;
            u32x4 w; w.x = pk4_fp8(y0[0], y0[1], y0[2], y0[3]); w.y = pk4_fp8(y1[0], y1[1], y1[2], y1[3]); w.z = pk4_fp8(y2[0], y2[1], y2[2], y2[3]); w.w = pk4_fp8(y3[0], y3[1], y3[2], y3[3]);
            *(u32x4*)(yr + (size_t)row * DM + col) = w; }
    }
};

__device__ __forceinline__ void p2_conv(Ctx& C, const Args& a, int first, int nwg) { C.tid = fresh_tid(); C.lane = C.tid & 63;
    const bf16_t* cv = (const bf16_t*)(C.ws + WS_CV); const bf16_t* bq = (const bf16_t*)(C.ws + WS_BQ); bf16_t* ac = (bf16_t*)(C.ws + WS_ACONV); const float* cw = a.in[I_CONVW];
    const int c8 = (C.tid & 63) * 8, rsub = C.tid >> 6;
    f32x4 w[3][2];
#pragma unroll
    for (int k = 0; k < 3; ++k) { w[k][0] = *(const f32x4*)(cw + k * DC + c8); w[k][1] = *(const f32x4*)(cw + k * DC + c8 + 4); }
    for (int rb0 = (C.vcu - first) * 8; rb0 < T; rb0 += nwg * 32) {
        u32x4 r0[4], r1[4], r2[4], rq[4];
#pragma unroll
        for (int u = 0; u < 4; ++u) { const int row = rb0 + u * nwg * 8 + rsub, t = row & (SEQ - 1); const size_t off = (size_t)row * DC + c8; const u32x4 z4 = {0u, 0u, 0u, 0u};
            r0[u] = z4; r1[u] = z4; r2[u] = z4; rq[u] = z4;
            if (row < T) { r0[u] = *(const u32x4*)(cv + off); rq[u] = *(const u32x4*)(bq + off);
                if (t >= 1) r1[u] = *(const u32x4*)(cv + off - DC);
                if (t >= 2) r2[u] = *(const u32x4*)(cv + off - 2 * DC); } }
#pragma unroll
        for (int u = 0; u < 4; ++u) { const int row = rb0 + u * nwg * 8 + rsub; const size_t off = (size_t)row * DC + c8;
            f32x4 h0a, h0b, h1a, h1b, h2a, h2b, ba, bb;
            unpack8(r0[u], h0a, h0b); unpack8(rq[u], ba, bb); unpack8(r1[u], h1a, h1b); unpack8(r2[u], h2a, h2b);
            const f32x4 za = w[0][0] * h2a + w[1][0] * h1a + w[2][0] * h0a, zb = w[0][1] * h2b + w[1][1] * h1b + w[2][1] * h0b;
            if (row < T) *(u32x4*)(ac + off) = pack8(ba * za, bb * zb); }
    }
}

__device__ __forceinline__ void p6_router(Ctx& C, const Args& a) { C.tid = fresh_tid(); C.lane = C.tid & 63;
    LAS bf16_t* wh = (LAS bf16_t*)C.lds;
    LAS bf16_t* wl = wh + 32 * WRS;
    LAS int* lcount = (LAS int*)(C.lds + P6X_OFF);
    LAS int* lbase = lcount + 32;
    LAS int* tk = lbase + 32;
    LAS float* g2s = (LAS float*)(tk + 512);
    const float* br = a.in[I_BR]; const float* g2 = a.in[I_G2]; const bf16_t* x1 = (const bf16_t*)(C.ws + WS_X1B);
    const float* rss = (const float*)((const unsigned*)(C.ws + WS_CTL) + CW_RSS);
    unsigned char* h2q = C.ws + WS_H2B; float* gates = (float*)(C.ws + WS_GATES); unsigned* slots = (unsigned*)(C.ws + WS_SLOTS);
    int* list = (int*)(C.ws + WS_LIST); unsigned* counts = (unsigned*)(C.ws + WS_CTL) + CW_CNT + (a.flags ? 4096 : 0);
    const int tid = C.tid, lane = C.lane, wave = C.wave, r = lane & 15, kg = lane >> 4;
    __syncthreads();
    { const unsigned char* img = C.ws + WS_WRIMG;
      for (int k = wave; k < 2 * 32 * WRS * 2 / 1024; k += NWAVES) __builtin_amdgcn_global_load_lds((const unsigned*)(img + k * 1024 + lane * 16), (LAS unsigned*)(C.lds + k * 1024), 16, 0, 0); }
    for (int i = tid; i < DM; i += NTHR) g2s[i] = g2[i];
    const float bias0 = br[r], bias1 = br[16 + r];
    for (int blk = C.vcu; blk < T / 128; blk += C.G) {
        if (tid < 32) lcount[tid] = 0;
        __syncthreads();
        const int tok_r = blk * 128 + wave * 16 + r;
        const float rs = rsqrtf(rss[tok_r] * (1.f / DM) + RMS_EPS);
        const bf16_t* xrow = x1 + (size_t)tok_r * DM + 8 * kg; unsigned char* qrow = h2q + (size_t)tok_r * DM + 8 * kg;
        f32x4 acc0 = {0.f, 0.f, 0.f, 0.f}, acc1 = acc0;
        u32x4 xw[2][8];
#pragma unroll
        for (int i = 0; i < 8; ++i) xw[0][i] = *(const u32x4*)(xrow + 32 * i);
        if (blk == C.vcu) { asm volatile("s_waitcnt vmcnt(0)" ::: "memory"); __syncthreads(); }
#pragma unroll
        for (int sb = 0; sb < 4; ++sb) { const int s8 = sb * 8;
            if (sb + 1 < 4) {
#pragma unroll
                for (int i = 0; i < 8; ++i) xw[(sb + 1) & 1][i] = *(const u32x4*)(xrow + 32 * (s8 + 8 + i)); }
#pragma unroll
            for (int i = 0; i < 8; ++i) { const int s = s8 + i;
                const f32x4 ga = *(const LAS f32x4*)(g2s + 32 * s + 8 * kg), gb = *(const LAS f32x4*)(g2s + 32 * s + 8 * kg + 4);
                f32x4 v0, v1; unpack8(xw[sb & 1][i], v0, v1); v0 = v0 * rs * ga; v1 = v1 * rs * gb;
                u32x2 q; q.x = pk4_fp8(v0[0], v0[1], v0[2], v0[3]); q.y = pk4_fp8(v1[0], v1[1], v1[2], v1[3]); *(u32x2*)(qrow + 32 * s) = q;
                const u32x4 hi = pack8(v0, v1); f32x4 h0, h1; unpack8(hi, h0, h1); const u32x4 lo = pack8(v0 - h0, v1 - h1);
                const bf16x8 ah = __builtin_bit_cast(bf16x8, hi), al = __builtin_bit_cast(bf16x8, lo);
                const bf16x8 bh0 = *(const LAS bf16x8*)(wh + r * WRS + 32 * s + 8 * kg), bh1 = *(const LAS bf16x8*)(wh + (16 + r) * WRS + 32 * s + 8 * kg);
                const bf16x8 bl0 = *(const LAS bf16x8*)(wl + r * WRS + 32 * s + 8 * kg), bl1 = *(const LAS bf16x8*)(wl + (16 + r) * WRS + 32 * s + 8 * kg);
                acc0 = __builtin_amdgcn_mfma_f32_16x16x32_bf16(ah, bh0, acc0, 0, 0, 0); acc1 = __builtin_amdgcn_mfma_f32_16x16x32_bf16(ah, bh1, acc1, 0, 0, 0);
                acc0 = __builtin_amdgcn_mfma_f32_16x16x32_bf16(al, bh0, acc0, 0, 0, 0); acc1 = __builtin_amdgcn_mfma_f32_16x16x32_bf16(al, bh1, acc1, 0, 0, 0);
                acc0 = __builtin_amdgcn_mfma_f32_16x16x32_bf16(ah, bl0, acc0, 0, 0, 0); acc1 = __builtin_amdgcn_mfma_f32_16x16x32_bf16(ah, bl1, acc1, 0, 0, 0); }
        }
#pragma unroll
        for (int reg = 0; reg < 4; ++reg) {
            float v0 = acc0[reg] + bias0, v1 = acc1[reg] + bias1;
            float tv0 = 0.f, tv1 = 0.f, tv2 = 0.f, tv3 = 0.f; int te0 = 0, te1 = 0, te2 = 0, te3 = 0;
#pragma unroll
            for (int k = 0; k < 4; ++k) {
                float mx = fmaxf(v0, v1);
#pragma unroll
                for (int o = 1; o < 16; o <<= 1) mx = fmaxf(mx, __shfl_xor(mx, o));
                const unsigned b0 = (unsigned)(__ballot(v0 == mx) >> (16 * kg)) & 0xffffu, b1 = (unsigned)(__ballot(v1 == mx) >> (16 * kg)) & 0xffffu;
                const int e = b0 ? __builtin_ctz(b0) : 16 + __builtin_ctz(b1 | 0x10000u);
                if (k == 0) { tv0 = mx; te0 = e; } else if (k == 1) { tv1 = mx; te1 = e; } else if (k == 2) { tv2 = mx; te2 = e; } else { tv3 = mx; te3 = e; }
                const bool mine = r == (e & 15);
                v0 = (mine && e < 16) ? -INFINITY : v0; v1 = (mine && e >= 16) ? -INFINITY : v1;
            }
            const float e1 = __expf(tv1 - tv0), e2 = __expf(tv2 - tv0), e3 = __expf(tv3 - tv0), inv = 1.f / (1.f + e1 + e2 + e3);
            if (r < 4) {
                const int k = r; const int e = k == 0 ? te0 : k == 1 ? te1 : k == 2 ? te2 : te3;
                const float gk = (k == 0 ? 1.f : k == 1 ? e1 : k == 2 ? e2 : e3) * inv;
                const int tl = wave * 16 + 4 * kg + reg;
                const int pl = atomicAdd((int*)&lcount[e], 1);
                tk[tl * 4 + k] = e | (pl << 8);
                gates[(size_t)(blk * 128 + tl) * 4 + k] = gk;
            }
        }
        __syncthreads();
        if (tid < 32) lbase[tid] = (int)__hip_atomic_fetch_add(counts + tid * 64, (unsigned)lcount[tid], RLX_AGENT);
        __syncthreads();
        { const int v = tk[tid], e = v & 255, pl = v >> 8, tl = tid >> 2, tok = blk * 128 + tl, pos = lbase[e] + pl;
          list[(size_t)e * T + pos] = tok; slots[(size_t)tok * 4 + (tid & 3)] = ((unsigned)e << 16) | (unsigned)pos; }
        __syncthreads();
    }
}

__device__ __forceinline__ void moe_tables(Ctx& C, LAS int* tstart, LAS int* cnt) { C.tid = fresh_tid(); C.lane = C.tid & 63;
    const unsigned* counts = (const unsigned*)(C.ws + WS_CTL) + CW_CNT;
    __syncthreads();
    if (C.tid < 32) cnt[C.tid] = (int)__hip_atomic_load(counts + C.tid * 64, RLX_AGENT);
    __syncthreads();
    if (C.tid == 0) { int s = 0; for (int e = 0; e < NE; ++e) { tstart[e] = s; s += (cnt[e] + 255) >> 8; } tstart[NE] = s; }
    __syncthreads();
    LAS int* pexp = tstart + 192;
    for (int e = 0; e < NE; ++e) for (int p = tstart[e] + C.tid; p < tstart[e + 1]; p += NTHR) pexp[p] = e;
    __syncthreads();
}

__device__ __forceinline__ void p9_combine(Ctx& C, const Args& a, const LAS int* tstart) { C.tid = fresh_tid(); C.lane = C.tid & 63;
    const unsigned char* yr = C.ws + WS_YROWS; const float* gates = (const float*)(C.ws + WS_GATES); const unsigned* slots = (const unsigned*)(C.ws + WS_SLOTS);
    float* out = a.out; const float* gf = a.in[I_GF];
    const int gw = C.vcu * NWAVES + C.wave, NGW = C.G * NWAVES, lane = C.lane;
    f32x4 gv[4];
#pragma unroll
    for (int j = 0; j < 4; ++j) gv[j] = ((const f32x4*)gf)[lane + 64 * j];
    for (int tok = gw; tok < T; tok += NGW) {
        const u32x2* xr = (const u32x2*)((const bf16_t*)(C.ws + WS_X1B) + (size_t)tok * DM) + lane; f32x4* xw = (f32x4*)(out + (size_t)tok * DM) + lane; f32x4 v[4];
#pragma unroll
        for (int j = 0; j < 4; ++j) { const u32x2 w_ = __builtin_nontemporal_load(xr + 64 * j); v[j] = (f32x4){bf_lo(w_.x), bf_hi(w_.x), bf_lo(w_.y), bf_hi(w_.y)}; }
        const u32x4 sl = *(const u32x4*)(slots + (size_t)tok * 4); const f32x4 gk = *(const f32x4*)(gates + (size_t)tok * 4);
#pragma unroll
        for (int k = 0; k < 4; ++k) { const unsigned s = sl[k]; const int e = (int)(s >> 16), pos = (int)(s & 0xffffu); const size_t row = (size_t)tstart[e] * 256 + pos;
            const unsigned* yp = (const unsigned*)(yr + row * DM) + lane;
#pragma unroll
            for (int j = 0; j < 4; ++j) { const unsigned w = __builtin_nontemporal_load(yp + 64 * j); const f32x2 lo = __builtin_amdgcn_cvt_pk_f32_fp8((int)w, false), hi = __builtin_amdgcn_cvt_pk_f32_fp8((int)w, true);
                v[j] = v[j] + gk[k] * (f32x4){lo.x, lo.y, hi.x, hi.y}; } }
        float s = 0.f;
#pragma unroll
        for (int j = 0; j < 4; ++j) s += (v[j].x * v[j].x + v[j].y * v[j].y) + (v[j].z * v[j].z + v[j].w * v[j].w);
        const float rs = rsqrtf(wave_sum(s) * (1.f / DM) + RMS_EPS);
#pragma unroll
        for (int j = 0; j < 4; ++j) __builtin_nontemporal_store(v[j] * rs * gv[j], xw + 64 * j);
    }
}


__device__ unsigned g_bar[4096];
constexpr int XB_EXIT = 3456;

constexpr int NPH = 10;
__global__ void __launch_bounds__(NTHR, 2) mk_fwd(Args args_k) {
#define args args_k
    extern __shared__ __attribute__((aligned(16))) unsigned char lds_raw[];
    Ctx C; C.lds = (LAS unsigned char*)lds_raw; C.tid = threadIdx.x; C.lane = C.tid & 63; C.wave = __builtin_amdgcn_readfirstlane(C.tid >> 6);
    C.G = gridDim.x; { const int bx = blockIdx.x; C.vcu = (C.G % 8 == 0) ? (bx % 8) * (C.G / 8) + bx / 8 : bx; }
    C.ws = args_k.ws;
    volatile LAS unsigned* MISC = (volatile LAS unsigned*)(C.lds + LCTL_OFF);
    LAS int* tstart = (LAS int*)(C.lds + LCTL_OFF + 256);
    LAS int* cnt = tstart + 40;
    for (int u = C.tid; u < (LDS_BYTES - LCTL_OFF) / 4; u += NTHR) ((LAS unsigned*)(C.lds + LCTL_OFF))[u] = 0u;
    __syncthreads();
    XcdBarrier bar; bar.bar = (unsigned*)(C.ws + WS_CTL) + CW_BAR; bar.x = 0; bar.st = nullptr;
    if (MK_N_LAUNCHES == 1) bar = xcd_barrier_post(g_bar, MISC + 8);
    const int lo = args_k.ph_lo, hi = args_k.ph_hi;
#ifndef PH_MASK
#define PH_MASK 0x3ff
#endif
#define IN(k) (((PH_MASK >> (k)) & 1) && lo <= (k) && (k) < hi)
#define SEAM(k) do { if (IN(k) && IN((k) + 1)) xcd_barrier(bar); } while (0)
    unsigned char* ws = C.ws;
    const int bid = (int)blockIdx.x;

    if (IN(0)) for (int rep = 0; rep < (PROBE_DUP == 0 ? 2 : 1); ++rep) { p0_prep(C, args); } SEAM(0);

    if (IN(1)) for (int rep = 0; rep < (PROBE_DUP == 1 ? 2 : 1); ++rep) {
        { DenseOrder S; S.init(ws + WS_XB, DM, ws + WS_WIN, DM, T, NBF, DM, C.G, bid);
          EpiInProj E{(bf16_t*)(ws + WS_CV), (bf16_t*)(ws + WS_BQ), (bf16_t*)(ws + WS_AG), ws + WS_SGA, ws + WS_SGB};
          pg8::gemm_phase<EpiInProj, DenseOrder, true, true>(C.lds, S, E); }
        { DenseOrder S; S.init(ws + WS_H2B, DM / 2, ws + WS_WIN8, DM / 2, T, DIN - NBF, DM / 2, C.G, bid);
          EpiGate8 E{ws + WS_SGA, ws + WS_SGB, (bf16_t*)(ws + WS_AG)};
          pg8::gemm_phase<EpiGate8, DenseOrder, true, true, true>(C.lds, S, E); }
    } SEAM(1);

    if (IN(2)) for (int rep = 0; rep < (PROBE_DUP == 2 ? 2 : 1); ++rep) {
        GroupOrder S; S.init(ws + WS_AG + AGU * 2, AGK, (size_t)AGROWS * AGK * 2, ws + WS_PT, DM, (size_t)256 * 1024 * 2, AGROWS, 256, CL * GC, C.G, C.vcu);
        EpiScan E{(bf16_t*)(ws + WS_AG), (const float*)(ws + WS_LAML)};
        pg8::gemm_phase<EpiScan, GroupOrder, false, true>(C.lds, S, E);
        if (C.G > 64) { if (C.vcu >= 64) p2_conv(C, args, 64, C.G - 64); } else p2_conv(C, args, 0, C.G);
    } SEAM(2);

    if (IN(3)) for (int rep = 0; rep < (PROBE_DUP == 3 ? 2 : 1); ++rep) {
        { ToepOrder S; S.init(ws + WS_AG, AGK, (size_t)AGROWS * AGK * 2, ws + WS_MQT, AGK, (size_t)1024 * AGK * 2, AGROWS, CL * GC, AGK, C.G, C.vcu); S.tri = true; S.TB = (const char*)(ws + WS_KTAB);
          EpiY E{(const bf16_t*)(ws + WS_AG), args.in[I_D], ws + WS_YB};
          pg8::gemm_phase<EpiY, ToepOrder, true, true>(C.lds, S, E); }
    } SEAM(3);

    if (IN(4)) for (int rep = 0; rep < (PROBE_DUP == 4 ? 2 : 1); ++rep) {
        { DenseOrder S; S.init(ws + WS_ACONV, DS, ws + WS_WCO, DS, T, DM, DS, C.G, bid);
          EpiYa E{ws + WS_SGA, (bf16_t*)(ws + WS_T1)};
          pg8::gemm_phase<EpiYa, DenseOrder, true, true>(C.lds, S, E); }
        { GluOrder S; S.K = DS / 2; S.ldb = DS / 2; S.lda = DS / 2; S.A = (const char*)(ws + WS_YB); S.B = (const char*)(ws + WS_WGLU); S.D.init(nullptr, 0, nullptr, 0, T, DM, DS, C.G, bid);
          EpiGlu E{ws + WS_SGB, (bf16_t*)(ws + WS_T1)};
          pg8::gemm_phase<EpiGlu, GluOrder, true, true, true>(C.lds, S, E); }
    } SEAM(4);

    if (IN(5)) for (int rep = 0; rep < (PROBE_DUP == 5 ? 2 : 1); ++rep) {
        DenseOrder S; S.init(ws + WS_T1, DM, ws + WS_WOUT, DM, T, DM, DM, C.G, bid);
        EpiOut E{args.in[I_X], (bf16_t*)(ws + WS_X1B), (float*)((unsigned*)(ws + WS_CTL) + CW_RSS)};
        pg8::gemm_phase<EpiOut, DenseOrder, true, true>(C.lds, S, E);
    } SEAM(5);

    if (IN(6)) for (int rep = 0; rep < (PROBE_DUP == 6 ? 2 : 1); ++rep) { p6_router(C, args); } SEAM(6);

    if (IN(7)) for (int rep = 0; rep < (PROBE_DUP == 7 ? 2 : 1); ++rep) {
        moe_tables(C, tstart, cnt);
        MoeOrder<true> S; S.K = DM / 2; S.ldb = DM / 2; S.lda = DM / 2; S.A = (const char*)(ws + WS_H2B); S.B = (const char*)(ws + WS_WGU); S.strideB = (size_t)2 * DFF * DM; S.npn = 8; S.G = C.G; S.c = bid;
        S.list = (const int*)(ws + WS_LIST); S.tstart = tstart; S.cnt = cnt;
        EpiGU E{(const float*)(ws + WS_BGU32), ws + WS_ACT, C.lds};
        pg8::gemm_phase<EpiGU, MoeOrder<true>, true, true, true>(C.lds, S, E);
    } SEAM(7);

    if (IN(8)) for (int rep = 0; rep < (PROBE_DUP == 8 ? 2 : 1); ++rep) {
        if (MK_N_LAUNCHES != 1) moe_tables(C, tstart, cnt);
        MoeOrder<false> S; S.K = DFF / 2; S.ldb = DFF / 2; S.lda = ACT_LD / 2; S.A = (const char*)(ws + WS_ACT); S.B = (const char*)(ws + WS_WD); S.strideB = (size_t)DM * DFF; S.npn = 4; S.G = C.G; S.c = bid;
        S.list = nullptr; S.tstart = tstart; S.cnt = cnt;
        EpiDown E{args.in[I_BD], ws + WS_YROWS, C.lds};
        pg8::gemm_phase<EpiDown, MoeOrder<false>, true, true, true>(C.lds, S, E);
    } SEAM(8);

    if (IN(9)) for (int rep = 0; rep < (PROBE_DUP == 9 ? 2 : 1); ++rep) { if (MK_N_LAUNCHES != 1) moe_tables(C, tstart, cnt); p9_combine(C, args, tstart); }
    if (MK_N_LAUNCHES == 1) {
        if (threadIdx.x == 0) MISC[4] = (xb_add(&g_bar[XB_EXIT], 1u) == (unsigned)C.G - 1u) ? 1u : 0u;
        __syncthreads();
        if (MISC[4]) for (int i = threadIdx.x; i < 4096; i += NTHR) __hip_atomic_store(&g_bar[i], 0u, __ATOMIC_RELAXED, __HIP_MEMORY_SCOPE_AGENT);
    }
#undef IN
#undef SEAM
}

extern "C" void kernel_launch(void* const* d_in, const int* in_sizes, int n_in, void* d_out, int out_size, void* d_ws, size_t ws_size, hipStream_t stream) {
    static int grid = 0;
    if (grid == 0) {
        if (n_in != 23 || out_size != T * DM || ws_size < WS_END) { fprintf(stderr, "kernel_launch: unexpected problem (n_in %d, out %d, ws %zu)\n", n_in, out_size, ws_size); grid = -1; return; }
        int dev = 0, cus = 0, per_cu = 0;
        if (hipGetDevice(&dev) != hipSuccess || hipDeviceGetAttribute(&cus, hipDeviceAttributeMultiprocessorCount, dev) != hipSuccess) { grid = -1; return; }
        if (hipFuncSetAttribute((const void*)mk_fwd, hipFuncAttributeMaxDynamicSharedMemorySize, LDS_BYTES) != hipSuccess) { fprintf(stderr, "kernel_launch: hipFuncSetAttribute failed\n"); grid = -1; return; }
        if (hipOccupancyMaxActiveBlocksPerMultiprocessor(&per_cu, (const void*)mk_fwd, NTHR, LDS_BYTES) != hipSuccess || per_cu < 1) { fprintf(stderr, "kernel_launch: occupancy query says %d\n", per_cu); per_cu = 1; }
        (void)hipGetLastError();
        grid = cus * (per_cu < 1 ? per_cu : 1);
    }
    if (grid < 0) return;
    if (MK_N_LAUNCHES != 1) (void)hipMemsetAsync((char*)d_ws + WS_CTL, 0, CTL_ZERO_BYTES, stream);
    Args a{};
    for (int i = 0; i < 23; ++i) a.in[i] = (const float*)d_in[i];
    a.out = (float*)d_out; a.ws = (unsigned char*)d_ws;
    if (MK_N_LAUNCHES == 1) {
        a.ph_lo = 0; a.ph_hi = NPH;
        void* kargs[] = {&a};
        hipError_t e = hipLaunchCooperativeKernel((const void*)mk_fwd, dim3(grid), dim3(NTHR), kargs, LDS_BYTES, stream);
        if (e != hipSuccess) fprintf(stderr, "kernel_launch: cooperative launch failed: %s\n", hipGetErrorString(e));
    } else {
        for (int p = 0; p < NPH; ++p) {
            if (p == PROBE_DUP_HOST) { a.ph_lo = p; a.ph_hi = p + 1; a.flags = 1; hipLaunchKernelGGL(mk_fwd, dim3(grid), dim3(NTHR), LDS_BYTES, stream, a); a.flags = 0; }
            a.ph_lo = p; a.ph_hi = p + 1; hipLaunchKernelGGL(mk_fwd, dim3(grid), dim3(NTHR), LDS_BYTES, stream, a); }
    }
}
```
